# Optimizing an MI355X kernel written in HIP

```python
import jax, jax.numpy as jnp
from jax import lax
import numpy as np

D_MODEL = 4096
BATCH = 2
SEQ = 4096
DEPTH = 2

HEAD_DIM = 128
BLOCK = 128
A_HEADS = 10
A_KV_HEADS = 2
A_WINDOW = 128
B_HEADS = 10
B_KV_HEADS = 1
IDX_HEADS = 16
IDX_DIM = 64
B_TOPK_MAX = 256
C_GROUPS = ((128, 1), (512, 4), (2048, 16))
C_N_GROUPS = 3
C_HEADS_PER_GROUP = 4
C_HEADS = C_N_GROUPS * C_HEADS_PER_GROUP
D_FF = 11008
CONV_WIDTH = 3
ROPE_THETA = 10000.0
EPS = 1e-6

SPLITS = (
    A_HEADS * HEAD_DIM, A_KV_HEADS * HEAD_DIM, A_KV_HEADS * HEAD_DIM,
    B_HEADS * HEAD_DIM, B_KV_HEADS * HEAD_DIM, B_KV_HEADS * HEAD_DIM,
    IDX_HEADS * IDX_DIM, IDX_DIM, IDX_HEADS,
    C_HEADS * HEAD_DIM, C_N_GROUPS * HEAD_DIM, C_N_GROUPS * HEAD_DIM,
    D_MODEL, D_MODEL, D_MODEL,
)
N_IN = sum(SPLITS)

kernel_name = "hybrid_gated_swa_dsa_dilated_convffn"


def _split_points():
    return [int(v) for v in np.cumsum(SPLITS)[:-1]]


def rmsnorm(x, g):
    xf = x.astype(jnp.float32)
    y = xf * lax.rsqrt(jnp.mean(xf * xf, axis=-1, keepdims=True) + EPS)
    return (y * g.astype(jnp.float32)).astype(x.dtype)


def rope_tables(T, dim):
    pos = jnp.arange(T, dtype=jnp.float32)
    inv = ROPE_THETA ** (-jnp.arange(0, dim, 2, dtype=jnp.float32) / dim)
    ang = pos[:, None] * inv[None, :]
    return jnp.cos(ang), jnp.sin(ang)


def apply_rope(x, cos, sin):
    xf = x.astype(jnp.float32)
    x1, x2 = jnp.split(xf, 2, axis=-1)
    c, s = cos[None, :, None, :], sin[None, :, None, :]
    return jnp.concatenate([x1 * c - x2 * s, x2 * c + x1 * s], axis=-1).astype(x.dtype)


def sliding_window_sink_attn(q, k, v, sinks):
    B_, T, H, D = q.shape
    KV = k.shape[2]
    G = H // KV
    nb = T // BLOCK
    qb = q.reshape(B_, nb, BLOCK, KV, G, D)

    def with_prev(z):
        zb = z.reshape(B_, nb, BLOCK, KV, D)
        prev = jnp.pad(zb, ((0, 0), (1, 0), (0, 0), (0, 0), (0, 0)))[:, :-1]
        return jnp.concatenate([prev, zb], axis=2)

    kb, vb = with_prev(k), with_prev(v)
    s = jnp.einsum('bnqkgd,bnskd->bnkgqs', qb, kb).astype(jnp.float32) * (D ** -0.5)
    qloc = jnp.arange(BLOCK)[:, None] + BLOCK
    kloc = jnp.arange(2 * BLOCK)[None, :]
    dist = qloc - kloc
    band = (dist >= 0) & (dist < A_WINDOW)
    kabs = jnp.arange(nb)[:, None] * BLOCK - BLOCK + jnp.arange(2 * BLOCK)[None, :]
    mask = band[None] & (kabs >= 0)[:, None, :]
    s = jnp.where(mask[None, :, None, None], s, -jnp.inf)
    sink = sinks.astype(jnp.float32).reshape(KV, G)[None, None, :, :, None, None]
    m = jnp.maximum(jnp.max(s, axis=-1, keepdims=True), sink)
    p = jnp.exp(s - m)
    denom = jnp.sum(p, axis=-1, keepdims=True) + jnp.exp(sink - m)
    o = jnp.einsum('bnkgqs,bnskd->bnqkgd', (p / denom).astype(v.dtype), vb)
    return o.reshape(B_, T, H * D)


def dsa_sparse_attn(q, k, v, q_idx, k_idx, w_idx, topk):
    B_, T, H, D = q.shape
    nb = T // BLOCK
    kpos = jnp.arange(T)

    def blk(z):
        return jnp.moveaxis(z.reshape(B_, nb, BLOCK, *z.shape[2:]), 1, 0)

    def one_block(args):
        n, qb, qib, wb = args
        qpos = n * BLOCK + jnp.arange(BLOCK)
        logits = jnp.einsum('bqhe,bse->bqhs', qib, k_idx).astype(jnp.float32)
        score = jnp.einsum('bqh,bqhs->bqs', wb.astype(jnp.float32), jax.nn.relu(logits))
        causal = kpos[None, :] <= qpos[:, None]
        score = jnp.where(causal[None], score, -jnp.inf)
        _, sel = lax.top_k(score, topk)
        valid = sel <= qpos[None, :, None]
        ksel = jax.vmap(lambda kk, ii: kk[ii])(k, sel)
        vsel = jax.vmap(lambda vv, ii: vv[ii])(v, sel)
        s = jnp.einsum('bqhd,bqkd->bhqk', qb, ksel).astype(jnp.float32) * (D ** -0.5)
        s = jnp.where(valid[:, None], s, -jnp.inf)
        p = jax.nn.softmax(s, axis=-1)
        return jnp.einsum('bhqk,bqkd->bqhd', p.astype(v.dtype), vsel)

    out = lax.map(one_block, (jnp.arange(nb), blk(q), blk(q_idx), blk(w_idx)))
    return jnp.moveaxis(out, 0, 1).reshape(B_, T, H * D)


def dilated_attn(q, k, v):
    B_, T, H, D = q.shape
    nb = T // BLOCK
    qg = jnp.moveaxis(q.reshape(B_, nb, BLOCK, C_N_GROUPS, C_HEADS_PER_GROUP, D), 1, 0)
    k_groups = [k[:, :, g] for g in range(C_N_GROUPS)]
    v_groups = [v[:, :, g] for g in range(C_N_GROUPS)]

    def one_block(args):
        n, qb = args
        qpos = n * BLOCK + jnp.arange(BLOCK)
        outs, lses = [], []
        for g, (win, dil) in enumerate(C_GROUPS):
            offs = jnp.arange(win // dil + 1) * dil
            kidx = qpos[:, None] - offs[None, :]
            valid = kidx >= 0
            kidx = jnp.maximum(kidx, 0)
            kg = k_groups[g][:, kidx]
            vg = v_groups[g][:, kidx]
            s = jnp.einsum('bqhd,bqkd->bhqk', qb[:, :, g], kg).astype(jnp.float32) * (D ** -0.5)
            s = jnp.where(valid[None, None], s, -jnp.inf)
            lse = jax.nn.logsumexp(s, axis=-1)
            p = jnp.exp(s - lse[..., None])
            outs.append(jnp.einsum('bhqk,bqkd->bqhd', p.astype(vg.dtype), vg).astype(jnp.float32))
            lses.append(lse)
        alpha = jax.nn.softmax(jnp.stack(lses, axis=0), axis=0)
        alpha = jnp.transpose(alpha, (0, 1, 3, 2))[..., None]
        o = jnp.sum(alpha * jnp.stack(outs, axis=0), axis=0)
        return o.astype(q.dtype)

    out = lax.map(one_block, (jnp.arange(nb), qg))
    return jnp.moveaxis(out, 0, 1).reshape(B_, T, C_HEADS_PER_GROUP * D)


def conv_ffn(h, w_up, conv_w, conv_b, w_down):
    T = h.shape[1]
    u = h @ w_up
    up = jnp.pad(u, ((0, 0), (CONV_WIDTH - 1, 0), (0, 0)))
    c = conv_b
    for j in range(CONV_WIDTH):
        c = c + up[:, j:j + T] * conv_w[j]
    gate, val = jnp.split(c, 2, axis=-1)
    return (jax.nn.silu(gate) * val) @ w_down


def setup_inputs(seed: int = 0) -> dict:
    key = jax.random.key(seed)
    ks = jax.random.split(key, 14)
    f32 = jnp.float32
    n = lambda k, shape, scale: jax.random.normal(k, shape, f32) * scale
    return {
        "x": n(ks[0], (BATCH, SEQ, D_MODEL), 1.0),
        "norm1_g": 1.0 + n(ks[1], (DEPTH, D_MODEL), 0.02),
        "w_in": n(ks[2], (DEPTH, D_MODEL, N_IN), D_MODEL ** -0.5),
        "qk_gain": 1.0 + n(ks[3], (DEPTH, 6, HEAD_DIM), 0.02),
        "sinks": n(ks[4], (DEPTH, A_HEADS), 0.5),
        "w_br_a": n(ks[5], (DEPTH, A_HEADS * HEAD_DIM, D_MODEL), (A_HEADS * HEAD_DIM) ** -0.5),
        "w_br_b": n(ks[6], (DEPTH, B_HEADS * HEAD_DIM, D_MODEL), (B_HEADS * HEAD_DIM) ** -0.5),
        "w_br_c": n(ks[7], (DEPTH, C_HEADS_PER_GROUP * HEAD_DIM, D_MODEL), (C_HEADS_PER_GROUP * HEAD_DIM) ** -0.5),
        "w_out": n(ks[8], (DEPTH, D_MODEL, D_MODEL), D_MODEL ** -0.5),
        "norm2_g": 1.0 + n(ks[9], (DEPTH, D_MODEL), 0.02),
        "w_up": n(ks[10], (DEPTH, D_MODEL, 2 * D_FF), D_MODEL ** -0.5),
        "conv_w": n(ks[11], (DEPTH, CONV_WIDTH, 2 * D_FF), CONV_WIDTH ** -0.5),
        "conv_b": n(ks[12], (DEPTH, 2 * D_FF), 0.01),
        "w_down": n(ks[13], (DEPTH, D_FF, D_MODEL), D_FF ** -0.5),
    }


def reference(x, norm1_g, w_in, qk_gain, sinks, w_br_a, w_br_b, w_br_c, w_out,
              norm2_g, w_up, conv_w, conv_b, w_down):
    B_, T, _ = x.shape
    topk = min(B_TOPK_MAX, T // 4)
    cos, sin = rope_tables(T, HEAD_DIM)
    cos_i, sin_i = rope_tables(T, IDX_DIM)
    points = _split_points()

    def heads(z, nh):
        return z.reshape(B_, T, nh, -1)

    for l in range(DEPTH):
        h = rmsnorm(x, norm1_g[l])
        proj = h @ w_in[l]
        (qa, ka, va, qb, kb, vb, qi, ki, wi, qc, kc, vc, ga, gb, gc) = jnp.split(proj, points, axis=-1)
        g = qk_gain[l]
        qa = apply_rope(rmsnorm(heads(qa, A_HEADS), g[0]), cos, sin)
        ka = apply_rope(rmsnorm(heads(ka, A_KV_HEADS), g[1]), cos, sin)
        oa = sliding_window_sink_attn(qa, ka, heads(va, A_KV_HEADS), sinks[l])
        qb = apply_rope(rmsnorm(heads(qb, B_HEADS), g[2]), cos, sin)
        kb = apply_rope(rmsnorm(heads(kb, B_KV_HEADS), g[3]), cos, sin)[:, :, 0]
        qi = apply_rope(heads(qi, IDX_HEADS), cos_i, sin_i)
        ki = apply_rope(heads(ki, 1), cos_i, sin_i)[:, :, 0]
        ob = dsa_sparse_attn(qb, kb, vb, qi, ki, wi, topk)
        qc = apply_rope(rmsnorm(heads(qc, C_HEADS), g[4]), cos, sin)
        kc = apply_rope(rmsnorm(heads(kc, C_N_GROUPS), g[5]), cos, sin)
        oc = dilated_attn(qc, kc, heads(vc, C_N_GROUPS))
        y = (jax.nn.sigmoid(ga) * (oa @ w_br_a[l])
             + jax.nn.sigmoid(gb) * (ob @ w_br_b[l])
             + jax.nn.sigmoid(gc) * (oc @ w_br_c[l]))
        x = x + y @ w_out[l]
        x = x + conv_ffn(rmsnorm(x, norm2_g[l]), w_up[l], conv_w[l], conv_b[l], w_down[l])
    return x
```

```cpp
#include <hip/hip_runtime.h>
#include <cstdio>
#include <cstdint>

#ifndef MK_N_LAUNCHES
#define MK_N_LAUNCHES 1
#endif

#define DI __device__ __forceinline__
#define GAS __attribute__((address_space(1)))
template <class T> __device__ __forceinline__ T* glob(T* p) { return (T*)(GAS T*)(unsigned long long)p; }
#define LAS __attribute__((address_space(3)))
typedef unsigned short bf16_t;
typedef short bf16x8 __attribute__((ext_vector_type(8)));
typedef float f32x4 __attribute__((ext_vector_type(4)));
typedef float f32x2 __attribute__((ext_vector_type(2)));
typedef unsigned u32x4 __attribute__((ext_vector_type(4)));
typedef unsigned u32x2 __attribute__((ext_vector_type(2)));
typedef __bf16 nbf16x2 __attribute__((ext_vector_type(2)));
typedef bf16x8 __attribute__((may_alias)) bf16x8_a;
typedef u32x4 __attribute__((may_alias)) u32x4_a;
typedef u32x2 __attribute__((may_alias)) u32x2_a;
typedef unsigned __attribute__((may_alias)) u32_a;
typedef unsigned short __attribute__((may_alias)) u16_a;

DI unsigned pk2(float lo, float hi) { f32x2 v = {lo, hi}; nbf16x2 r = __builtin_convertvector(v, nbf16x2); return __builtin_bit_cast(unsigned, r); }
#define CL8(x) __builtin_amdgcn_fmed3f((x), -448.0f, 448.0f)
DI float bf_lo(unsigned u) { return __uint_as_float(u << 16); }
DI float bf_hi(unsigned u) { return __uint_as_float(u & 0xffff0000u); }
DI float bf1(bf16_t h) { return __uint_as_float(((unsigned)h) << 16); }
DI float wave_sum(float v) {
#pragma unroll
    for (int o = 1; o < 64; o <<= 1) v += __shfl_xor(v, o);
    return v;
}
#define MFMA16(a, b, c) __builtin_amdgcn_mfma_f32_16x16x32_bf16((a), (b), (c), 0, 0, 0)

constexpr int NB = 2, T = 4096, D = 4096, M = NB * T, DEPTH = 2;
constexpr int N_IN = 19024, NPROJ = 19200;
constexpr int C_QI = 0, C_KI = 1024, C_WI = 1088, C_KA = 1104, C_KB = 1360, C_KC = 1488,   C_VA = 2048, C_VB = 2304, C_VC = 2432,
              C_QA = 2816, C_QB = 4096, C_QC = 5376, C_GA = 6912, C_GB = 11008, C_GC = 15104;
DI int proj_col(int n) {
    return n < 1280 ? C_QA + n : n < 1536 ? C_KA + (n - 1280) : n < 1792 ? C_VA + (n - 1536) : n < 3072 ? C_QB + (n - 1792) : n < 3200 ? C_KB + (n - 3072) : n < 3328 ? C_VB + (n - 3200)
         : n < 4432 ? n - 3328 : n < 5968 ? C_QC + (n - 4432) : n < 6352 ? C_KC + (n - 5968) : n < 6736 ? C_VC + (n - 6352) : C_GA + (n - 6736);
}
constexpr int DFF = 11008, NUP = 2 * DFF;
constexpr int NB16 = 2048, NG8 = NPROJ - NB16;
constexpr float G8_SCALE = 64.0f;
constexpr float O8_SCALE = 16.0f, WBR8_SCALE = 32.0f, Y8_SCALE = 16.0f, WOUT8_SCALE = 64.0f;
constexpr int KBR_A = 1280, KBR_B = 1280, KBR_C = 512;
constexpr float EPS = 1e-6f;
constexpr float LOG2E = 1.4426950408889634f, LN2 = 0.6931471805599453f;
constexpr float QSCALE = 0.08838834764831845f * LOG2E;
constexpr int TOPK = 256;
constexpr int VTP = T + 64;

constexpr size_t MiB = 1u << 20;
constexpr size_t WS_CTL = 0, CTL_ZERO_BYTES = 1 * MiB;
constexpr size_t WS_COS128 = 2 * MiB, WS_SIN128 = 3 * MiB, WS_COS64 = 4 * MiB, WS_SIN64 = 4 * MiB + 512 * 1024;
constexpr size_t WS_W = 8 * MiB, LW = 464 * MiB;
constexpr size_t LW_IN = 0, LW_BRA = 150 * MiB, LW_BRB = 160 * MiB, LW_BRC = 170 * MiB, LW_OUT = 174 * MiB, LW_UP = 206 * MiB, LW_DN = 378 * MiB;
constexpr size_t WS_H = 936 * MiB, WS_PROJ = 1000 * MiB, WS_VTA = 1300 * MiB, WS_VTC = 1304 * MiB, WS_OCG = 1310 * MiB, WS_LSE = 1358 * MiB,
                 WS_OA = 1359 * MiB, WS_OB = 1379 * MiB, WS_OC = 1399 * MiB, WS_Y = 1407 * MiB, WS_U = 1471 * MiB, WS_ACT = 1815 * MiB, WS_PART = 1987 * MiB  ,
                 WS_QA = 1990 * MiB  , WS_KA = 2010 * MiB  , WS_QB = 2014 * MiB  , WS_KB = 2034 * MiB  , WS_VB = 2036 * MiB,
                 WS_QI = 2038 * MiB  , WS_KI = 2054 * MiB  , WS_WI = 2055 * MiB  , WS_QC = 2056 * MiB  , WS_KC = 2080 * MiB  ,
                 WS_VTA2 = 2086 * MiB  , WS_VTC2 = 2091 * MiB  ,
                 WS_FIX = 2098 * MiB  , WS_HALO = 2104 * MiB  ,
                 WS_H8 = 2107 * MiB  , WS_WG8 = 2139 * MiB  ,
                 WS_Y8 = 2279 * MiB  , WS_END = 2311 * MiB;
static_assert(WS_WG8 + (size_t)DEPTH * NG8 * D <= WS_Y8, "fp8 in-proj weights");
static_assert((size_t)NPROJ * D * 2 == 150 * MiB && (size_t)NUP * D * 2 == 172 * MiB && (size_t)D * DFF * 2 == 86 * MiB && (size_t)M * NPROJ * 2 == 300 * MiB, "ws map");
static_assert((size_t)M * NUP * 2 == 344 * MiB && (size_t)M * DFF * 2 == 172 * MiB && (size_t)3 * M * 512 * 4 == 48 * MiB, "ws map");
constexpr size_t WS_SS = 512 * 1024;
constexpr int CW_BAR = 4096;

constexpr int LDS_BYTES = 163840;
constexpr int MISC_OFF = LDS_BYTES - 256;
constexpr int NWAVES = 8;
static __device__ const float INV128[64] = {1.0f, 0.865964353f, 0.749894261f, 0.649381638f, 0.562341332f, 0.486967534f, 0.421696514f, 0.365174115f, 0.316227764f, 0.273841977f, 0.237137377f, 0.2053525f, 0.177827939f, 0.153992653f, 0.133352131f, 0.115478203f, 0.100000001f, 0.0865964293f, 0.0749894157f, 0.0649381652f, 0.0562341325f, 0.0486967526f, 0.0421696529f, 0.0365174115f, 0.0316227749f, 0.0273841973f, 0.0237137377f, 0.0205352511f, 0.0177827943f, 0.0153992651f, 0.0133352149f, 0.0115478206f, 0.00999999978f, 0.00865964312f, 0.00749894185f, 0.00649381615f, 0.00562341325f, 0.00486967526f, 0.00421696482f, 0.00365174119f, 0.00316227763f, 0.00273841969f, 0.00237137359f, 0.00205352483f, 0.00177827943f, 0.00153992651f, 0.00133352145f, 0.0011547819f, 0.00100000005f, 0.000865964335f, 0.000749894243f, 0.000649381662f, 0.000562341302f, 0.000486967532f, 0.000421696517f, 0.000365174143f, 0.000316227757f, 0.000273841957f, 0.00023713737f, 0.00020535251f, 0.00017782794f, 0.000153992645f, 0.00013335215f, 0.0001154782f};
static __device__ const float INV64[32] = {1.0f, 0.749894261f, 0.562341332f, 0.421696514f, 0.316227764f, 0.237137377f, 0.177827939f, 0.133352131f, 0.100000001f, 0.0749894157f, 0.0562341325f, 0.0421696529f, 0.0316227749f, 0.0237137377f, 0.0177827943f, 0.0133352149f, 0.00999999978f, 0.00749894185f, 0.00562341325f, 0.00421696482f, 0.00316227763f, 0.00237137359f, 0.00177827943f, 0.00133352145f, 0.00100000005f, 0.000749894243f, 0.000562341302f, 0.000421696517f, 0.000316227757f, 0.00023713737f, 0.00017782794f, 0.00013335215f};

#ifndef PG8_WGM
#define PG8_WGM 8
#endif
namespace pg8 {
#define PG8_LAS __attribute__((address_space(3)))
typedef unsigned short bf16_t;
typedef short bf16x8 __attribute__((ext_vector_type(8)));
typedef float f32x4 __attribute__((ext_vector_type(4)));
typedef unsigned u32x4 __attribute__((ext_vector_type(4)));
constexpr int BM = 256, BK = 64, HALF = 128, HTB = HALF * BK * 2  , STAGE_BYTES = 8 * HTB, NXCD = 8, WGM = PG8_WGM;

__host__ __device__ __forceinline__ int lds_byte(int r, int c) { const int st = (r >> 4) * 2 + (c >> 5), rr = r & 15, cc = c & 31, ob = rr * 64 + cc * 2; return st * 1024 + (ob ^ (((ob >> 9) & 1) << 5)); }
__host__ __device__ __forceinline__ void stage_rc(int b, int& R, int& C) { const int st = b / 1024, sb = b % 1024, swz = sb ^ (((sb >> 9) & 1) << 5); R = (st >> 1) * 16 + swz / 64; C = (st & 1) * 32 + (swz % 64) / 2; }
__host__ __device__ __forceinline__ int perm32(int rho) { const int n = rho >> 4, i = rho & 15; return 8 * (i >> 2) + 4 * n + (i & 3); }

struct Unit { int pm, pn; };
struct Gemm { const bf16_t* A; const bf16_t* Bt; int M, N, K; };

struct StaticOrder {
    int nM, nN, nwg, G, c;
    __host__ __device__ void init(int M, int N, int G_, int c_) { nM = M / BM; nN = N / BM; nwg = nM * nN; G = G_; c = c_; }
    __host__ __device__ bool next(int i, Unit& u) const {
        const long L = (long)i * G + c; if (L >= nwg) return false;
        int wgid = (int)L; { const int q = nwg / NXCD, r = nwg % NXCD, xcd = wgid % NXCD, off = wgid / NXCD; wgid = (xcd < r ? xcd * (q + 1) : r * (q + 1) + (xcd - r) * q) + off; }
        const int nig = WGM * nN, gid = wgid / nig, fm = gid * WGM, gsz = (nM - fm) < WGM ? (nM - fm) : WGM;
        u.pm = fm + ((wgid % nig) % gsz); u.pn = (wgid % nig) / gsz; return true;
    }
    __device__ __forceinline__ void a_ready(const Unit&) const {}
    __device__ __forceinline__ void done(const Unit&) const {}
};

#define PG8_GAS __attribute__((address_space(1)))
constexpr int XL_OFF = 131072, XL_WAVE = 3040, XL_BUF = 1520, XL_RS = 80;
struct EpiStoreBf16 {
    static constexpr bool PERM = true, AFTER_DRAIN = false;
    bf16_t* O; int ldc; const float* ss; float inv_k, eps; PG8_LAS unsigned char* xl; float mul;
    __device__ __forceinline__ void operator()(const f32x4 (&acc)[2][2][4][2], const Unit& u, int wr, int wc, int fr_, int fq_) const {
        int fr = fr_, fq = fq_; asm volatile("" : "+v"(fr), "+v"(fq));
        const int rowb = u.pm * BM + wr * 64, colb = u.pn * BM + wc * 32, lr = fq * 4 + (fr >> 2), lp = fr & 3;
        float rsl[2];
        { const PG8_GAS float* sp = (const PG8_GAS float*)ss + rowb + (fq * 16 + fr); const float s0 = sp[0], s1 = sp[HALF];
          rsl[0] = mul / sqrtf(s0 * inv_k + eps); rsl[1] = mul / sqrtf(s1 * inv_k + eps); }
#pragma unroll
        for (int ai = 0; ai < 2; ++ai)
#pragma unroll
            for (int m = 0; m < 4; ++m) { const int rb = rowb + ai * HALF + m * 16;
                const float rs = __shfl(rsl[ai], m * 16 + fr);
#pragma unroll
                for (int bj = 0; bj < 2; ++bj) { const f32x4 v0 = acc[ai][bj][m][0] * rs, v1 = acc[ai][bj][m][1] * rs;
                    PG8_LAS unsigned char* buf = xl + bj * XL_BUF;
                    u32x4 w; w.x = pk2(v0[0], v0[1]); w.y = pk2(v0[2], v0[3]); w.z = pk2(v1[0], v1[1]); w.w = pk2(v1[2], v1[3]);
                    *(PG8_LAS u32x4*)(buf + fr * XL_RS + fq * 16) = w;
                    const u32x4 t = *(const PG8_LAS u32x4*)(buf + lr * XL_RS + lp * 16);
                    *(u32x4*)(O + (size_t)(rb + lr) * ldc + colb + bj * HALF + lp * 8) = t; } }
    }
};
struct EpiGate {
    static constexpr bool PERM = true, AFTER_DRAIN = false;
    bf16_t* Y; int ldy; const bf16_t* G; int ldg; int first; PG8_LAS unsigned char* xl; float mul; unsigned char* Y8; float y8s;
    __device__ __forceinline__ void operator()(const f32x4 (&acc)[2][2][4][2], const Unit& u, int wr, int wc, int fr_, int fq_) const {
        int fr = fr_, fq = fq_; asm volatile("" : "+v"(fr), "+v"(fq));
        const int rowb = u.pm * BM + wr * 64, colb = u.pn * BM + wc * 32, lr = fq * 4 + (fr >> 2), lp = fr & 3;
        u32x4 gvb[2][2], yvb[2][2];
#define EG_LOAD(k_) do { const size_t row_ = (size_t)(rowb + ((k_) >> 2) * HALF + ((k_) & 3) * 16 + lr); _Pragma("unroll") for (int bj = 0; bj < 2; ++bj) { \
            gvb[(k_) & 1][bj] = *(const u32x4*)(G + row_ * ldg + colb + bj * HALF + lp * 8); \
            yvb[(k_) & 1][bj] = (u32x4){0u, 0u, 0u, 0u}; if (!first) yvb[(k_) & 1][bj] = *(const u32x4*)(Y + row_ * ldy + colb + bj * HALF + lp * 8); } } while (0)
        EG_LOAD(0);
#pragma unroll
        for (int k = 0; k < 8; ++k) { const int ai = k >> 2, m = k & 3; const size_t row = (size_t)(rowb + ai * HALF + m * 16 + lr);
                if (k < 7) EG_LOAD(k + 1);
                const u32x4 (&gv)[2] = gvb[k & 1]; const u32x4 (&yv)[2] = yvb[k & 1];
#pragma unroll
                for (int bj = 0; bj < 2; ++bj) { const f32x4 v0 = acc[ai][bj][m][0], v1 = acc[ai][bj][m][1];
                    PG8_LAS unsigned char* buf = xl + bj * XL_BUF;
                    u32x4 w; w.x = pk2(v0[0], v0[1]); w.y = pk2(v0[2], v0[3]); w.z = pk2(v1[0], v1[1]); w.w = pk2(v1[2], v1[3]);
                    *(PG8_LAS u32x4*)(buf + fr * XL_RS + fq * 16) = w;
                    const u32x4 t = *(const PG8_LAS u32x4*)(buf + lr * XL_RS + lp * 16);
                    u32x4 o; int yq[2] = {0, 0};
#pragma unroll
                    for (int q = 0; q < 4; ++q) { const unsigned gw = gv[bj][q], yw = yv[bj][q], aw = t[q];
                        const float s0 = __builtin_amdgcn_rcpf(1.0f + __expf(-bf_lo(gw))), s1 = __builtin_amdgcn_rcpf(1.0f + __expf(-bf_hi(gw)));
                        const float y0 = bf_lo(yw) + s0 * mul * bf_lo(aw), y1 = bf_hi(yw) + s1 * mul * bf_hi(aw);
                        o[q] = pk2(y0, y1); if (q & 1) yq[q >> 1] = __builtin_amdgcn_cvt_pk_fp8_f32(CL8(y0 * y8s), CL8(y1 * y8s), yq[q >> 1], true); else yq[q >> 1] = __builtin_amdgcn_cvt_pk_fp8_f32(CL8(y0 * y8s), CL8(y1 * y8s), yq[q >> 1], false); }
                    *(u32x4*)(Y + row * ldy + colb + bj * HALF + lp * 8) = o;
                    if (Y8) { u32x2 w8; w8.x = (unsigned)yq[0]; w8.y = (unsigned)yq[1]; *(u32x2*)(Y8 + row * ldy + colb + bj * HALF + lp * 8) = w8; } } }
#undef EG_LOAD
    }
};
struct EpiResid {
    static constexpr bool PERM = false, AFTER_DRAIN = false;
    const float* R; float* O; int ldc; bf16_t* Hn; const float* gn; float* ssn; PG8_LAS unsigned char* xl; unsigned char* H8n; float mul;
    __device__ __forceinline__ void operator()(const f32x4 (&acc)[2][2][4][2], const Unit& u, int wr, int wc, int fr_, int fq_) const {
        int fr = fr_, fq = fq_; asm volatile("" : "+v"(fr), "+v"(fq));
        const int rowb = u.pm * BM + wr * 64, colb = u.pn * BM + wc * 32, lr = fq * 4 + (fr >> 2), lp = fr & 3;
        f32x4 gv[2][2];
#pragma unroll
        for (int bj = 0; bj < 2; ++bj)
#pragma unroll
            for (int n = 0; n < 2; ++n) gv[bj][n] = Hn ? *(const f32x4*)(gn + colb + bj * HALF + n * 16 + lp * 4) : (f32x4){0.f, 0.f, 0.f, 0.f};
        f32x4 rvb[2][2][2];
#define ER_LOAD(k_) do { const size_t off_ = (size_t)(rowb + ((k_) >> 2) * HALF + ((k_) & 3) * 16 + lr) * ldc + colb + lp * 4; _Pragma("unroll") for (int bj = 0; bj < 2; ++bj) _Pragma("unroll") for (int n = 0; n < 2; ++n) \
            rvb[(k_) & 1][bj][n] = *(const f32x4*)(R + off_ + bj * HALF + n * 16); } while (0)
        ER_LOAD(0);
#pragma unroll
        for (int k = 0; k < 8; ++k) { const int ai = k >> 2, m = k & 3; const int row = rowb + ai * HALF + m * 16 + lr; const size_t off = (size_t)row * ldc + colb + lp * 4;
                if (k < 7) ER_LOAD(k + 1);
                const f32x4 (&rv)[2][2] = rvb[k & 1];
                float sq = 0.f;
#pragma unroll
                for (int bj = 0; bj < 2; ++bj)
#pragma unroll
                    for (int n = 0; n < 2; ++n) {
                        PG8_LAS unsigned char* buf = xl + n * XL_BUF;
                        *(PG8_LAS f32x4*)(buf + fr * XL_RS + fq * 16) = acc[ai][bj][m][n];
                        const f32x4 t = *(const PG8_LAS f32x4*)(buf + lr * XL_RS + lp * 16);
                        const f32x4 x = rv[bj][n] + t * mul; *(f32x4*)(O + off + bj * HALF + n * 16) = x;
                        if (Hn) { sq += (x[0] * x[0] + x[1] * x[1]) + (x[2] * x[2] + x[3] * x[3]); const f32x4 y = x * gv[bj][n];
                            u32x2 w; w.x = pk2(y[0], y[1]); w.y = pk2(y[2], y[3]); *(u32x2*)(Hn + off + bj * HALF + n * 16) = w;
                            if (H8n) { int q8 = 0; q8 = __builtin_amdgcn_cvt_pk_fp8_f32(CL8(y[0]), CL8(y[1]), q8, false); q8 = __builtin_amdgcn_cvt_pk_fp8_f32(CL8(y[2]), CL8(y[3]), q8, true); *(unsigned*)(H8n + off + bj * HALF + n * 16) = (unsigned)q8; } } }
                if (Hn) { sq += __shfl_xor(sq, 1); sq += __shfl_xor(sq, 2);
                    if (lp == 0) ssn[(size_t)row * 64 + u.pn * 4 + wc] = sq; } }
#undef ER_LOAD
    }
};
typedef __bf16 nbf2 __attribute__((ext_vector_type(2)));
#define DOT2(a, b, c) __builtin_amdgcn_fdot2_f32_bf16(__builtin_bit_cast(nbf2, (unsigned)(a)), __builtin_bit_cast(nbf2, (unsigned)(b)), (c), false)
constexpr int XCH_OFF = XL_OFF + 8 * XL_WAVE, XCH_SLOT = 256;
struct EpiConv {
    static constexpr bool PERM = true, AFTER_DRAIN = false;
    bf16_t* ACT; const float* ss; float inv_k, eps; const float* cw; const float* cb; float* FIX; bf16_t* HALO; PG8_LAS unsigned char* lds0; int wid, dff;
    __device__ __forceinline__ void operator()(const f32x4 (&acc)[2][2][4][2], const Unit& u, int wr, int wc, int fr_, int fq_) const {
        int fr = fr_, fq = fq_; asm volatile("" : "+v"(fr), "+v"(fq));
        const int rowb = u.pm * BM + wr * 64, lr = fq * 4 + (fr >> 2), lp = fr & 3, nup = 2 * dff;
        PG8_LAS unsigned char* xl = lds0 + XL_OFF + wid * XL_WAVE;
        PG8_LAS unsigned char* xch = lds0 + XCH_OFF;
        const int ch0 = u.pn * 128 + wc * 32 + lp * 8;
        f32x4 wraw;
        { const int j = lr, hf = j >> 3, kind = (j >> 1) & 3, part = j & 1;
          const float* src = (kind < 3 ? cw + (size_t)kind * nup : cb) + hf * dff + ch0 + part * 4; wraw = *(const f32x4*)src; }
        float rsl[2];
        { const PG8_GAS float* sp = (const PG8_GAS float*)ss + rowb + (fq * 16 + fr); const float s0 = sp[0], s1 = sp[HALF];
          rsl[0] = 1.0f / sqrtf(s0 * inv_k + eps); rsl[1] = 1.0f / sqrtf(s1 * inv_k + eps); }
#pragma unroll
        for (int ai = 0; ai < 2; ++ai) { const float rs = __shfl(rsl[ai], 48 + fr);
#pragma unroll
            for (int bj = 0; bj < 2; ++bj) { const f32x4 v0 = acc[ai][bj][3][0] * rs, v1 = acc[ai][bj][3][1] * rs;
                u32x4 w; w.x = pk2(v0[0], v0[1]); w.y = pk2(v0[2], v0[3]); w.z = pk2(v1[0], v1[1]); w.w = pk2(v1[2], v1[3]);
                if (fr >= 14) *(PG8_LAS u32x4*)(xch + ((ai * 2 + wr) * 4 + wc) * XCH_SLOT + bj * 128 + (fr - 14) * 64 + fq * 16) = w; } }
        asm volatile("s_waitcnt lgkmcnt(0)" ::: "memory"); __builtin_amdgcn_s_barrier(); asm volatile("" ::: "memory");
        PG8_LAS unsigned char* wlds = xch + 16 * XCH_SLOT + wid * 512 + lp * 128;
        {
            *(PG8_LAS f32x4*)(xl + (lr * 4 + lp) * 16) = wraw;
            if (lr == 0) {
#pragma unroll
                for (int hf = 0; hf < 2; ++hf) {
#pragma unroll
                    for (int pr = 0; pr < 2; ++pr) {
                        f32x4 t[4];
#pragma unroll
                        for (int k = 0; k < 4; ++k) t[k] = *(const PG8_LAS f32x4*)(xl + ((hf * 8 + pr * 4 + k) * 4 + lp) * 16);
                        u32x4 x0, x1;
#pragma unroll
                        for (int q = 0; q < 4; ++q) { x0[q] = pk2(t[0][q], t[2][q]); x1[q] = pk2(t[1][q], t[3][q]); }
                        *(PG8_LAS u32x4*)(wlds + hf * 64 + pr * 32) = x0; *(PG8_LAS u32x4*)(wlds + hf * 64 + pr * 32 + 16) = x1; }
                }
            }
        }
        const size_t tile = (size_t)u.pm * (dff / 128) + u.pn;
#pragma unroll
        for (int ai = 0; ai < 2; ++ai) {
            if (lr < 2) { u32x4 cg = {0u, 0u, 0u, 0u}, cv = {0u, 0u, 0u, 0u};
                if (wr == 1 || ai == 1) { const int ps = wr == 1 ? (ai * 2 + 0) * 4 + wc : (0 * 2 + 1) * 4 + wc;
                    cg = *(const PG8_LAS u32x4*)(xch + ps * XCH_SLOT + lr * 64 + lp * 16); cv = *(const PG8_LAS u32x4*)(xch + ps * XCH_SLOT + 128 + lr * 64 + lp * 16); }
                *(PG8_LAS u32x4*)(xl + lr * XL_RS + lp * 16) = cg; *(PG8_LAS u32x4*)(xl + XL_BUF + lr * XL_RS + lp * 16) = cv; }
#pragma unroll
            for (int m = 0; m < 4; ++m) { const int rb = rowb + ai * HALF + m * 16;
                const float rs = __shfl(rsl[ai], m * 16 + fr);
#pragma unroll
                for (int bj = 0; bj < 2; ++bj) { const f32x4 v0 = acc[ai][bj][m][0] * rs, v1 = acc[ai][bj][m][1] * rs;
                    u32x4 w; w.x = pk2(v0[0], v0[1]); w.y = pk2(v0[2], v0[3]); w.z = pk2(v1[0], v1[1]); w.w = pk2(v1[2], v1[3]);
                    *(PG8_LAS u32x4*)(xl + bj * XL_BUF + (2 + fr) * XL_RS + fq * 16) = w; }
                const bool top = (ai == 0) && (m == 0) && (wr == 0) && (lr < 2);
                const bool bot = (ai == 1) && (m == 3) && (wr == 1) && (lr >= 14);
                float sg[8];
                int wo = 0; asm volatile("" : "+v"(wo));
                {   u32x4 g[3], wa[2], wb[2];
#pragma unroll
                    for (int k = 0; k < 2; ++k) { wa[k] = *(const PG8_LAS u32x4*)(wlds + wo + k * 16); wb[k] = *(const PG8_LAS u32x4*)(wlds + wo + 32 + k * 16); }
#pragma unroll
                    for (int k = 0; k < 3; ++k) g[k] = *(const PG8_LAS u32x4*)(xl + (lr + k) * XL_RS + lp * 16);
                    if (lr >= 14) { *(PG8_LAS u32x4*)(xl + (lr - 14) * XL_RS + lp * 16) = g[2];
                        if (bot) { int l2 = lr, p2 = lp; asm volatile("" : "+v"(l2), "+v"(p2)); const int ho = (l2 - 14) * 256 + wc * 32 + p2 * 8; *(u32x4*)(HALO + tile * 512 + ho) = g[2]; } }
#pragma unroll
                    for (int q = 0; q < 4; ++q) {
                        const unsigned a_lo = __builtin_amdgcn_perm(g[1][q], g[0][q], 0x05040100u), a_hi = __builtin_amdgcn_perm(g[1][q], g[0][q], 0x07060302u);
                        const unsigned b_lo = __builtin_amdgcn_perm(0x3f803f80u, g[2][q], 0x05040100u), b_hi = __builtin_amdgcn_perm(0x3f803f80u, g[2][q], 0x07060302u);
                        sg[2 * q] = DOT2(b_lo, wb[q >> 1][(2 * q) & 3], DOT2(a_lo, wa[q >> 1][(2 * q) & 3], 0.f));
                        sg[2 * q + 1] = DOT2(b_hi, wb[q >> 1][(2 * q + 1) & 3], DOT2(a_hi, wa[q >> 1][(2 * q + 1) & 3], 0.f)); }
                    if (top) { int l2 = lr, p2 = lp; asm volatile("" : "+v"(l2), "+v"(p2)); const int fo = l2 * 256 + wc * 32 + p2 * 8; float* fx = FIX + tile * 512 + fo;
                        *(f32x4*)(fx) = (f32x4){sg[0], sg[1], sg[2], sg[3]}; *(f32x4*)(fx + 4) = (f32x4){sg[4], sg[5], sg[6], sg[7]}; }
#pragma unroll
                    for (int q = 0; q < 8; ++q) sg[q] = sg[q] * __builtin_amdgcn_rcpf(1.0f + __expf(-sg[q])); }
                {   u32x4 v[3], wa[2], wb[2];
#pragma unroll
                    for (int k = 0; k < 2; ++k) { wa[k] = *(const PG8_LAS u32x4*)(wlds + wo + 64 + k * 16); wb[k] = *(const PG8_LAS u32x4*)(wlds + wo + 96 + k * 16); }
#pragma unroll
                    for (int k = 0; k < 3; ++k) v[k] = *(const PG8_LAS u32x4*)(xl + XL_BUF + (lr + k) * XL_RS + lp * 16);
                    if (lr >= 14) { *(PG8_LAS u32x4*)(xl + XL_BUF + (lr - 14) * XL_RS + lp * 16) = v[2];
                        if (bot) { int l2 = lr, p2 = lp; asm volatile("" : "+v"(l2), "+v"(p2)); const int ho = (l2 - 14) * 256 + 128 + wc * 32 + p2 * 8; *(u32x4*)(HALO + tile * 512 + ho) = v[2]; } }
                    float cv[8];
#pragma unroll
                    for (int q = 0; q < 4; ++q) {
                        const unsigned a_lo = __builtin_amdgcn_perm(v[1][q], v[0][q], 0x05040100u), a_hi = __builtin_amdgcn_perm(v[1][q], v[0][q], 0x07060302u);
                        const unsigned b_lo = __builtin_amdgcn_perm(0x3f803f80u, v[2][q], 0x05040100u), b_hi = __builtin_amdgcn_perm(0x3f803f80u, v[2][q], 0x07060302u);
                        cv[2 * q] = DOT2(b_lo, wb[q >> 1][(2 * q) & 3], DOT2(a_lo, wa[q >> 1][(2 * q) & 3], 0.f));
                        cv[2 * q + 1] = DOT2(b_hi, wb[q >> 1][(2 * q + 1) & 3], DOT2(a_hi, wa[q >> 1][(2 * q + 1) & 3], 0.f)); }
                    if (top) { int l2 = lr, p2 = lp; asm volatile("" : "+v"(l2), "+v"(p2)); const int fo = l2 * 256 + 128 + wc * 32 + p2 * 8; float* fx = FIX + tile * 512 + fo;
                        *(f32x4*)(fx) = (f32x4){cv[0], cv[1], cv[2], cv[3]}; *(f32x4*)(fx + 4) = (f32x4){cv[4], cv[5], cv[6], cv[7]}; }
                    else { u32x4 o;
#pragma unroll
                        for (int q = 0; q < 4; ++q) o[q] = pk2(sg[2 * q] * cv[2 * q], sg[2 * q + 1] * cv[2 * q + 1]);
                        *(u32x4*)(ACT + (size_t)(rb + lr) * dff + ch0) = o; } }
            }
        }
    }
};

template <class Epi, class Sched, bool ALIGN_EPI = false, bool SP2 = false, bool FP8 = false>
__device__ __forceinline__ void gemm_phase(PG8_LAS unsigned char* lds, const Gemm g, const Sched& S, const Epi& E) {
    int tid_ = threadIdx.x; asm volatile("" : "+v"(tid_));
    const int tid = tid_, wid = __builtin_amdgcn_readfirstlane(tid >> 6), lane = tid & 63, wr = wid >> 2, wc = wid & 3, fr = lane & 15, fq = lane >> 4;
    const int K = g.K, nt = K / BK;
    unsigned voffA[2], voffB[2];
#pragma unroll
    for (int i = 0; i < 2; ++i) { int R, C; stage_rc(tid * 16 + i * 8192, R, C); const int Rb = Epi::PERM ? ((R & ~31) + perm32(R & 31)) : R;
        voffA[i] = (unsigned)(R * K + C) * 2u; voffB[i] = (unsigned)(Rb * K + C) * 2u; }
    const size_t kstep = (size_t)(BK * 2);
    const size_t hstep = (size_t)HALF * K * 2;
    const size_t tstep = 2 * hstep;
    const unsigned ldsw = (unsigned)wid * 1024u;
    const int aoff = lds_byte(wr * 64 + fr, fq * 8), boff = lds_byte(wc * 32 + fr, fq * 8);
#define PG8_SA(b, h) (((b) * 2 + (h)) * HTB)
#define PG8_SB(b, h) ((4 + (b) * 2 + (h)) * HTB)
#define PG8_STAGE(bufoff, gbase, voff) do { _Pragma("unroll") for (int _i = 0; _i < 2; ++_i) \
        __builtin_amdgcn_global_load_lds((const unsigned*)((const char*)(gbase) + (voff)[_i]), (PG8_LAS unsigned*)(lds + (bufoff) + ldsw + _i * 8192), 16, 0, 0); } while (0)
#define PG8_LDA(dst, b, h) do { _Pragma("unroll") for (int m = 0; m < 4; ++m) { if constexpr (FP8) { \
        const v4i_ lo_ = *(const PG8_LAS v4i_*)(lds + PG8_SA(b, h) + aoff + m * 2048), hi_ = *(const PG8_LAS v4i_*)(lds + PG8_SA(b, h) + aoff + m * 2048 + 1024); dst##8[m] = __builtin_shufflevector(lo_, hi_, 0, 1, 2, 3, 4, 5, 6, 7); } \
        else { _Pragma("unroll") for (int k = 0; k < 2; ++k) dst[m][k] = *(const PG8_LAS bf16x8*)(lds + PG8_SA(b, h) + aoff + m * 2048 + k * 1024); } } } while (0)
#define PG8_LDB(dst, b, h) do { _Pragma("unroll") for (int n = 0; n < 2; ++n) { if constexpr (FP8) { \
        const v4i_ lo_ = *(const PG8_LAS v4i_*)(lds + PG8_SB(b, h) + boff + n * 2048), hi_ = *(const PG8_LAS v4i_*)(lds + PG8_SB(b, h) + boff + n * 2048 + 1024); dst##8[n] = __builtin_shufflevector(lo_, hi_, 0, 1, 2, 3, 4, 5, 6, 7); } \
        else { _Pragma("unroll") for (int k = 0; k < 2; ++k) dst[n][k] = *(const PG8_LAS bf16x8*)(lds + PG8_SB(b, h) + boff + n * 2048 + k * 1024); } } } while (0)
#define PG8_MMA(ai, bj, At, Bt) do { __builtin_amdgcn_s_setprio(1); _Pragma("unroll") for (int m = 0; m < 4; ++m) _Pragma("unroll") for (int n = 0; n < 2; ++n) { \
        if constexpr (FP8) asm volatile("v_mfma_f32_16x16x128_f8f6f4 %0, %1, %2, %0" : "+v"(acc[ai][bj][m][n]) : "v"(Bt##8[n]), "v"(At##8[m]));     \
        else { _Pragma("unroll") for (int k = 0; k < 2; ++k) acc[ai][bj][m][n] = __builtin_amdgcn_mfma_f32_16x16x32_bf16(Bt[n][k], At[m][k], acc[ai][bj][m][n], 0, 0, 0); } } \
        __builtin_amdgcn_s_setprio(0); } while (0)
#define PG8_WAIT_V(n) asm volatile("s_waitcnt vmcnt(" #n ")" ::: "memory")
#define PG8_WAIT_L(n) asm volatile("s_waitcnt lgkmcnt(" #n ")" ::: "memory")
#define PG8_BAR __builtin_amdgcn_s_barrier()
#define PG8_SCHED __builtin_amdgcn_sched_barrier(0)
    Unit cur, nxt; int ui = 0;
    if (!S.next(0, cur)) return;
    f32x4 acc[2][2][4][2];
#pragma unroll
    for (int a = 0; a < 2; ++a)
#pragma unroll
        for (int b = 0; b < 2; ++b)
#pragma unroll
            for (int m = 0; m < 4; ++m)
#pragma unroll
                for (int n = 0; n < 2; ++n) acc[a][b][m][n] = (f32x4){0.f, 0.f, 0.f, 0.f};
    typedef int v4i_ __attribute__((ext_vector_type(4))); typedef int v8i_ __attribute__((ext_vector_type(8)));
    bf16x8 At[4][2], B0[2][2], B1[2][2]; v8i_ At8[4], B08[2], B18[2];
    const char* cA = (const char*)g.A + (size_t)cur.pm * tstep; const char* cB = (const char*)g.Bt + (size_t)cur.pn * tstep;
    S.a_ready(cur);
    if constexpr (SP2) {
        PG8_STAGE(PG8_SB(0, 0), cB, voffB); PG8_STAGE(PG8_SB(0, 1), cB + hstep, voffB); PG8_STAGE(PG8_SA(0, 0), cA, voffA); PG8_STAGE(PG8_SA(0, 1), cA + hstep, voffA);
        if (wr == 1) PG8_BAR;
        PG8_WAIT_V(2); PG8_BAR;
        PG8_STAGE(PG8_SB(1, 0), cB + kstep, voffB); PG8_STAGE(PG8_SA(1, 0), cA + kstep, voffA); PG8_STAGE(PG8_SB(1, 1), cB + hstep + kstep, voffB);
        PG8_WAIT_V(6); PG8_BAR;
    } else {
        PG8_STAGE(PG8_SB(0, 0), cB, voffB); PG8_STAGE(PG8_SA(0, 0), cA, voffA); PG8_STAGE(PG8_SB(0, 1), cB + hstep, voffB); PG8_STAGE(PG8_SA(0, 1), cA + hstep, voffA);
        if (wr == 1) PG8_BAR;
        PG8_WAIT_V(4); PG8_BAR;
        PG8_STAGE(PG8_SB(1, 0), cB + kstep, voffB); PG8_STAGE(PG8_SA(1, 0), cA + kstep, voffA); PG8_STAGE(PG8_SB(1, 1), cB + hstep + kstep, voffB);
        PG8_WAIT_V(6); PG8_BAR;
    }
    for (;;) {
        const bool has_next = S.next(ui + 1, nxt);
        const char* nA = has_next ? (const char*)g.A + (size_t)nxt.pm * tstep : cA; const char* nB = has_next ? (const char*)g.Bt + (size_t)nxt.pn * tstep : cB;
        for (int t = 0; t < nt; t += 2) {
            const bool last = (t == nt - 2);
            const char* a1 = cA + (size_t)(t + 1) * kstep;
            const char* a2 = last ? nA : cA + (size_t)(t + 2) * kstep; const char* b2 = last ? nB : cB + (size_t)(t + 2) * kstep;
            const char* a3 = a2 + kstep; const char* b3 = b2 + kstep;
            if (last && has_next) S.a_ready(nxt);
            if constexpr (SP2) {
            PG8_LDB(B0, 0, 0); PG8_LDB(B1, 0, 1); PG8_SCHED; PG8_LDA(At, 0, 0); PG8_STAGE(PG8_SA(1, 1), a1 + hstep, voffA);
            PG8_WAIT_V(8); PG8_WAIT_L(0); PG8_BAR; PG8_MMA(0, 0, At, B0); PG8_MMA(0, 1, At, B1); PG8_BAR; PG8_SCHED;
            PG8_LDA(At, 0, 1); PG8_STAGE(PG8_SB(0, 0), b2, voffB); PG8_STAGE(PG8_SB(0, 1), b2 + hstep, voffB); PG8_STAGE(PG8_SA(0, 0), a2, voffA);
            PG8_WAIT_V(8); PG8_WAIT_L(0); PG8_BAR; PG8_MMA(1, 0, At, B0); PG8_MMA(1, 1, At, B1); PG8_BAR; PG8_SCHED;
            PG8_LDB(B0, 1, 0); PG8_LDB(B1, 1, 1); PG8_SCHED; PG8_LDA(At, 1, 0); PG8_STAGE(PG8_SA(0, 1), a2 + hstep, voffA);
            PG8_WAIT_V(8); PG8_WAIT_L(0); PG8_BAR; PG8_MMA(0, 0, At, B0); PG8_MMA(0, 1, At, B1); PG8_BAR; PG8_SCHED;
            PG8_LDA(At, 1, 1); PG8_STAGE(PG8_SB(1, 0), b3, voffB); PG8_STAGE(PG8_SB(1, 1), b3 + hstep, voffB); PG8_STAGE(PG8_SA(1, 0), a3, voffA);
            PG8_WAIT_V(8); PG8_WAIT_L(0); PG8_BAR; PG8_MMA(1, 0, At, B0); PG8_MMA(1, 1, At, B1); PG8_BAR; PG8_SCHED;
            } else {
            PG8_LDB(B0, 0, 0); PG8_SCHED; PG8_LDA(At, 0, 0); PG8_STAGE(PG8_SA(1, 1), a1 + hstep, voffA);
            PG8_WAIT_L(8); PG8_BAR; PG8_WAIT_L(0); PG8_MMA(0, 0, At, B0); PG8_BAR; PG8_SCHED;
            PG8_LDB(B1, 0, 1); PG8_STAGE(PG8_SB(0, 0), b2, voffB);
            PG8_BAR; PG8_WAIT_L(0); PG8_MMA(0, 1, At, B1); PG8_BAR;
            PG8_LDA(At, 0, 1); PG8_STAGE(PG8_SA(0, 0), a2, voffA);
            PG8_BAR; PG8_WAIT_L(0); PG8_MMA(1, 0, At, B0); PG8_BAR; PG8_SCHED;
            PG8_STAGE(PG8_SB(0, 1), b2 + hstep, voffB);
            PG8_WAIT_V(6); PG8_BAR; PG8_MMA(1, 1, At, B1); PG8_BAR;
            PG8_LDB(B0, 1, 0); PG8_SCHED; PG8_LDA(At, 1, 0); PG8_STAGE(PG8_SA(0, 1), a2 + hstep, voffA);
            PG8_WAIT_L(8); PG8_BAR; PG8_WAIT_L(0); PG8_MMA(0, 0, At, B0); PG8_BAR; PG8_SCHED;
            PG8_LDB(B1, 1, 1); PG8_STAGE(PG8_SB(1, 0), b3, voffB);
            PG8_BAR; PG8_WAIT_L(0); PG8_MMA(0, 1, At, B1); PG8_BAR;
            PG8_LDA(At, 1, 1); PG8_STAGE(PG8_SA(1, 0), a3, voffA);
            PG8_BAR; PG8_WAIT_L(0); PG8_MMA(1, 0, At, B0); PG8_BAR; PG8_SCHED;
            PG8_STAGE(PG8_SB(1, 1), b3 + hstep, voffB);
            PG8_WAIT_V(6); PG8_BAR; PG8_MMA(1, 1, At, B1); PG8_BAR;
            }
        }
        if constexpr (ALIGN_EPI) { if (wr == 0) PG8_BAR; }
        if constexpr (!Epi::AFTER_DRAIN) { E(acc, cur, wr, wc, fr, fq); S.done(cur); }
        if (!has_next) break;
#pragma unroll
        for (int a = 0; a < 2; ++a)
#pragma unroll
            for (int b = 0; b < 2; ++b)
#pragma unroll
                for (int m = 0; m < 4; ++m)
#pragma unroll
                    for (int n = 0; n < 2; ++n) acc[a][b][m][n] = (f32x4){0.f, 0.f, 0.f, 0.f};
        cur = nxt; cA = nA; cB = nB; ++ui;
        if constexpr (ALIGN_EPI) { if (wr == 1) PG8_BAR; }
    }
    PG8_WAIT_V(0);
    if constexpr (!ALIGN_EPI) { if (wr == 0) PG8_BAR; }
    PG8_BAR;
    if constexpr (Epi::AFTER_DRAIN) { E.fused(acc, cur, wr, wc, fr, fq, lds, wid, lane); S.done(cur); }
#undef PG8_SA
#undef PG8_SB
#undef PG8_STAGE
#undef PG8_LDA
#undef PG8_LDB
#undef PG8_MMA
#undef PG8_WAIT_V
#undef PG8_WAIT_L
#undef PG8_BAR
#undef PG8_SCHED
}
}

#define XB_TMO      128
#define XB_XCNT(j)  (256  + 64 * (j))
#define XB_XSUB(j)  (1280 + 64 * (j))
#define XB_XGEN(j)  (2304 + 64 * (j))
#define XB_TOP      3328
#define XB_TOPGEN   3392
#define XCD_BAR_WORDS 3456
#define XB_SPIN_CAP (1u << 18)

__device__ __forceinline__ unsigned xb_ld(unsigned* p)              { return __hip_atomic_load(p, __ATOMIC_RELAXED, __HIP_MEMORY_SCOPE_AGENT); }
__device__ __forceinline__ unsigned xb_add(unsigned* p, unsigned v) { return __hip_atomic_fetch_add(p, v, __ATOMIC_RELAXED, __HIP_MEMORY_SCOPE_AGENT); }
__device__ __forceinline__ unsigned xb_xcc_id() { return (unsigned)__builtin_amdgcn_s_getreg((3 << 11) | 20) & 0xFu; }
#define XB_SPIN(cond, bar) do { unsigned _sp = 0; while (cond) { __builtin_amdgcn_s_sleep(1); \
    if ((++_sp & 255u) == 0u) { if (xb_ld(&(bar)[XB_TMO])) break; if (_sp > XB_SPIN_CAP) { atomicAdd(&(bar)[XB_TMO], 1u); break; } } } } while (0)

struct XcdBarrier {
    unsigned* bar; unsigned x;
    volatile LAS unsigned* st;
};

__device__ __forceinline__ XcdBarrier xcd_barrier_post(unsigned* bar, volatile LAS unsigned* st) {
    XcdBarrier b; b.bar = bar; b.x = xb_xcc_id(); b.st = st;
    if (threadIdx.x == 0) (void)xb_add(&bar[XB_XCNT(b.x)], 1u);
    return b;
}
__device__ __forceinline__ void xcd_barrier_complete(unsigned* bar, unsigned x, unsigned& nloc, unsigned& nx) {
    const unsigned G = gridDim.x * gridDim.y * gridDim.z;
    unsigned sum, cnt, mine, sp = 0u;
    for (;;) {
        sum = 0u; cnt = 0u; mine = 0u;
#pragma unroll
        for (unsigned j = 0; j < 16; ++j) { const unsigned c = xb_ld(&bar[XB_XCNT(j)]); sum += c; cnt += (c > 0u) ? 1u : 0u; mine = (j == x) ? c : mine; }
        if (sum == G) break;
        __builtin_amdgcn_s_sleep(1);
        if ((++sp & 255u) == 0u) { if (xb_ld(&bar[XB_TMO])) break; if (sp > XB_SPIN_CAP) { atomicAdd(&bar[XB_TMO], 1u); break; } }
    }
    nloc = mine > 0u ? mine : 1u; nx = cnt > 0u ? cnt : 1u;
}

__device__ __forceinline__ void xcd_barrier(const XcdBarrier& b) {
    asm volatile("s_waitcnt vmcnt(0)" ::: "memory");
    __syncthreads();
    if (threadIdx.x == 0) {
        unsigned* bar = b.bar;
        __builtin_amdgcn_s_waitcnt(0);
        unsigned nloc = b.st[0], nx = b.st[1];
        if (nloc == 0u) { xcd_barrier_complete(bar, b.x, nloc, nx); b.st[0] = nloc; b.st[1] = nx; }
        const unsigned old = xb_add(&bar[XB_XSUB(b.x)], 1u);
        const unsigned gen = old / nloc;
        if (old + 1u == (gen + 1u) * nloc) {
            __builtin_amdgcn_fence(__ATOMIC_RELEASE, "agent");
            asm volatile("s_waitcnt vmcnt(0)" ::: "memory");
            const unsigned og = xb_add(&bar[XB_TOP], 1u);
            const unsigned tg = og / nx;
            if (og + 1u == (tg + 1u) * nx) xb_add(&bar[XB_TOPGEN], 1u);
            else XB_SPIN(xb_ld(&bar[XB_TOPGEN]) == tg, bar);
            __builtin_amdgcn_fence(__ATOMIC_ACQUIRE, "agent");
            xb_add(&bar[XB_XGEN(b.x)], 1u);
            asm volatile("s_waitcnt vmcnt(0)" ::: "memory");
        } else {
            XB_SPIN(xb_ld(&bar[XB_XGEN(b.x)]) == gen, bar);
            __builtin_amdgcn_fence(__ATOMIC_ACQUIRE, "agent");
            asm volatile("s_waitcnt vmcnt(0)" ::: "memory");
        }
    }
    __syncthreads();
}

struct Frame {
    LAS unsigned char* lds;
    int tid, lane, wave, G, gw, ngw;
    unsigned char* ws;
    const float* const* in; float* out;
};

struct CvItem { const float* W; bf16_t* WT; unsigned char* W8; float sc8; int K, N, k0, n0, nd0; };
constexpr int CV_IN = 32 * 298, CV_BA = 10 * 64, CV_BC = 4 * 64, CV_OUT = 32 * 64, CV_UP = 32 * 344, CV_DN = 86 * 64;
constexpr int CV_PER_LAYER = CV_IN + 2 * CV_BA + CV_BC + CV_OUT + CV_UP + CV_DN;
#ifndef MK_CV_SPARE
#define MK_CV_SPARE 1000
#endif
constexpr int CV_SPARE_HI = CV_IN + MK_CV_SPARE;
#ifndef MK_CV_UP
#define MK_CV_UP 4000
#endif
constexpr int CV_UP_HI = CV_SPARE_HI + MK_CV_UP;
DI CvItem cv_decode(const float* const* in, unsigned char* wl, unsigned char* ws8, int l, int it) {
    int r = it; CvItem c;
    c.W8 = nullptr; c.sc8 = 1.0f;
    if (r < CV_IN) { c.W = glob(in[2]) + (size_t)l * D * N_IN; c.WT = (bf16_t*)(wl + LW_IN); c.K = D; c.N = N_IN; c.k0 = (r / 298) * 128; c.n0 = (r % 298) * 64; c.nd0 = c.n0;
        c.W8 = ws8 + (size_t)l * NG8 * D; c.sc8 = G8_SCALE; c.nd0 = -1; return c; }     r -= CV_IN;
    if (r < CV_BA) { c.W = glob(in[5]) + (size_t)l * KBR_A * D; c.WT = nullptr; c.W8 = wl + LW_BRA; c.sc8 = WBR8_SCALE; c.K = KBR_A; c.N = D; c.k0 = (r / 64) * 128; c.n0 = (r % 64) * 64; c.nd0 = c.n0; return c; } r -= CV_BA;
    if (r < CV_BA) { c.W = glob(in[6]) + (size_t)l * KBR_B * D; c.WT = nullptr; c.W8 = wl + LW_BRB; c.sc8 = WBR8_SCALE; c.K = KBR_B; c.N = D; c.k0 = (r / 64) * 128; c.n0 = (r % 64) * 64; c.nd0 = c.n0; return c; } r -= CV_BA;
    if (r < CV_BC) { c.W = glob(in[7]) + (size_t)l * KBR_C * D; c.WT = nullptr; c.W8 = wl + LW_BRC; c.sc8 = WBR8_SCALE; c.K = KBR_C; c.N = D; c.k0 = (r / 64) * 128; c.n0 = (r % 64) * 64; c.nd0 = c.n0; return c; } r -= CV_BC;
    if (r < CV_OUT) { c.W = glob(in[8]) + (size_t)l * D * D; c.WT = nullptr; c.W8 = wl + LW_OUT; c.sc8 = WOUT8_SCALE; c.K = D; c.N = D; c.k0 = (r / 64) * 128; c.n0 = (r % 64) * 64; c.nd0 = c.n0; return c; } r -= CV_OUT;
    if (r < CV_UP) { c.W = glob(in[10]) + (size_t)l * D * NUP; c.WT = (bf16_t*)(wl + LW_UP); c.K = D; c.N = NUP; c.k0 = (r / 344) * 128; c.n0 = (r % 344) * 64; { const int half = c.n0 >= DFF, ch = c.n0 - half * DFF; c.nd0 = 256 * (ch >> 7) + 128 * half + (ch & 127); } return c; } r -= CV_UP;
    c.W = glob(in[13]) + (size_t)l * DFF * D; c.WT = (bf16_t*)(wl + LW_DN); c.K = DFF; c.N = D; c.k0 = (r / 64) * 128; c.n0 = (r % 64) * 64; c.nd0 = c.n0; return c;
}
DI void cv_load(f32x4 (&v)[32], const CvItem& c, int lane) {
    const int r4 = lane >> 4, c4 = (lane & 15) * 4; const bool colok = (c.n0 + c4) < c.N;
    const float* p = c.W + (size_t)(c.k0 + r4) * c.N + c.n0 + c4;
#pragma unroll
    for (int i = 0; i < 32; ++i) v[i] = colok ? *(const f32x4*)(p + (size_t)(4 * i) * c.N) : (f32x4){0.f, 0.f, 0.f, 0.f};
}
DI void convert_items(Frame& F, const float* const* in, int l, int lo, int hi, int widx, int nw) {
    LAS u32_a* scr = (LAS u32_a*)(F.lds + F.wave * 16896);
    const LAS u16_a* s16 = (const LAS u16_a*)scr;
    unsigned char* wl = F.ws + WS_W + (size_t)l * LW;
    const int lane = F.lane, r4 = lane >> 4;
    int it = lo + widx;
    if (it >= hi) return;
    f32x4 v[32];
    unsigned char* ws8 = F.ws + WS_WG8;
    CvItem cur = cv_decode(in, wl, ws8, l, it);
    cv_load(v, cur, lane);
    for (;;) {
#pragma unroll
        for (int i = 0; i < 32; ++i) { const int k = i * 4 + r4; scr[k * 33 + (lane & 15) * 2] = pk2(v[i].x, v[i].y); scr[k * 33 + (lane & 15) * 2 + 1] = pk2(v[i].z, v[i].w); }
        const int nx = it + nw; const bool more = nx < hi;
        CvItem nxt = cur;
        if (more) { nxt = cv_decode(in, wl, ws8, l, nx); cv_load(v, nxt, lane); }
#pragma unroll 4
        for (int s = 0; s < 16; ++s) {
            const int n = (s >> 2) * 16 + (lane & 15), c = (s & 3) * 4 + (lane >> 4);
            const LAS u16_a* p = s16 + (8 * c) * 66 + n;
            u32x4 w;
            w.x = (unsigned)p[0 * 66] | ((unsigned)p[1 * 66] << 16); w.y = (unsigned)p[2 * 66] | ((unsigned)p[3 * 66] << 16);
            w.z = (unsigned)p[4 * 66] | ((unsigned)p[5 * 66] << 16); w.w = (unsigned)p[6 * 66] | ((unsigned)p[7 * 66] << 16);
            if (cur.n0 + n < cur.N) {
                int drow = cur.nd0 + n; bool to8 = cur.W8 != nullptr;
                if (cur.nd0 < 0) { const int pc = proj_col(cur.n0 + n); to8 = pc >= NB16; drow = to8 ? pc - NB16 : pc; }
                if (to8) { int lo = 0, hi = 0;
                    lo = __builtin_amdgcn_cvt_pk_fp8_f32(CL8(bf_lo(w.x) * cur.sc8), CL8(bf_hi(w.x) * cur.sc8), lo, false); lo = __builtin_amdgcn_cvt_pk_fp8_f32(CL8(bf_lo(w.y) * cur.sc8), CL8(bf_hi(w.y) * cur.sc8), lo, true);
                    hi = __builtin_amdgcn_cvt_pk_fp8_f32(CL8(bf_lo(w.z) * cur.sc8), CL8(bf_hi(w.z) * cur.sc8), hi, false); hi = __builtin_amdgcn_cvt_pk_fp8_f32(CL8(bf_lo(w.w) * cur.sc8), CL8(bf_hi(w.w) * cur.sc8), hi, true);
                    u32x2 w8; w8.x = (unsigned)lo; w8.y = (unsigned)hi; *(u32x2*)(cur.W8 + (size_t)drow * cur.K + cur.k0 + 8 * c) = w8; }
                else *(u32x4*)(cur.WT + (size_t)drow * cur.K + cur.k0 + 8 * c) = w; }
        }
        if (!more) break;
        cur = nxt; it = nx;
    }
}
DI void p_prologue(Frame& F, const float* const* in) {
    if (F.G == 256) {
        for (int l = 0; l < DEPTH; ++l) { convert_items(F, in, l, 0, CV_IN, F.gw, F.ngw); convert_items(F, in, l, l == 0 ? CV_SPARE_HI : CV_UP_HI, CV_PER_LAYER, F.gw, F.ngw); } }
    else { for (int l = 0; l < DEPTH; ++l) convert_items(F, in, l, 0, CV_PER_LAYER, F.gw, F.ngw); }
    for (int it = F.gw; it < DEPTH * 176; it += F.ngw) {
        const int l = it / 176, rr = 1872 + it % 176;
        u32x4* p = (u32x4*)(F.ws + WS_W + (size_t)l * LW + LW_IN + (size_t)rr * D * 2) + F.lane;
#pragma unroll
        for (int j = 0; j < 8; ++j) p[64 * j] = (u32x4){0u, 0u, 0u, 0u};
    }
    for (int t = F.gw; t < T; t += F.ngw) {
        const int i = F.lane;
        { const float inv = INV128[i]; const float ang = (float)t * inv; float sn, cs; sincosf(ang, &sn, &cs);
          ((float*)(F.ws + WS_COS128))[t * 64 + i] = cs; ((float*)(F.ws + WS_SIN128))[t * 64 + i] = sn; }
        if (i < 32) { const float inv = INV64[i]; const float ang = (float)t * inv; float sn, cs; sincosf(ang, &sn, &cs);
          ((float*)(F.ws + WS_COS64))[t * 32 + i] = cs; ((float*)(F.ws + WS_SIN64))[t * 32 + i] = sn; }
    }
}

DI void p_norm(Frame& F, const float* __restrict__ x, const float* __restrict__ g, bf16_t* __restrict__ H, unsigned char* __restrict__ H8, float* __restrict__ ss) {
    for (int m = F.gw; m < M; m += F.ngw) {
        const f32x4* xr = (const f32x4*)(x + (size_t)m * D) + F.lane;
        f32x4 v[16]; float sq = 0.f;
#pragma unroll
        for (int j = 0; j < 16; ++j) { v[j] = xr[64 * j]; sq += (v[j].x * v[j].x + v[j].y * v[j].y) + (v[j].z * v[j].z + v[j].w * v[j].w); }
        sq = wave_sum(sq);
        if (F.lane == 0) ss[m] = sq;
        u32x2* o = (u32x2*)(H + (size_t)m * D) + F.lane;
#pragma unroll
        for (int j = 0; j < 16; ++j) { const f32x4 gg = ((const f32x4*)g)[64 * j + F.lane];
            u32x2 w; w.x = pk2(v[j].x * gg.x, v[j].y * gg.y); w.y = pk2(v[j].z * gg.z, v[j].w * gg.w); o[64 * j] = w;
            int q8 = 0; q8 = __builtin_amdgcn_cvt_pk_fp8_f32(CL8(v[j].x * gg.x), CL8(v[j].y * gg.y), q8, false); q8 = __builtin_amdgcn_cvt_pk_fp8_f32(CL8(v[j].z * gg.z), CL8(v[j].w * gg.w), q8, true);
            ((unsigned*)(H8 + (size_t)m * D))[64 * j + F.lane] = (unsigned)q8; }
    }
}

DI void p_rowsum(Frame& F, const float* __restrict__ part, float* __restrict__ ss) {
    for (int m = F.gw; m < M; m += F.ngw) { const float s = wave_sum(part[(size_t)m * 64 + F.lane]); if (F.lane == 0) ss[m] = s; }
}

DI void prep_token(const bf16_t* __restrict__ P, int b, int t, const float* __restrict__ gain, unsigned char* __restrict__ ws, int lane) {
    const int h = lane >> 5, lp = lane & 31;
    const int qd = lane >> 4, lq = lane & 15;
    const f32x2 cs = *(const f32x2*)((const float*)(ws + WS_COS128) + t * 64 + 2 * lp), sn = *(const f32x2*)((const float*)(ws + WS_SIN128) + t * 64 + 2 * lp);
    const f32x2 cs6 = *(const f32x2*)((const float*)(ws + WS_COS64) + t * 32 + 2 * lq), sn6 = *(const f32x2*)((const float*)(ws + WS_SIN64) + t * 32 + 2 * lq);
    unsigned xa[19], xb[19]; f32x2 g1[19], g2[19]; unsigned ya[5], yb[5];
#pragma unroll
    for (int it = 0; it < 19; ++it) {
        const int hh = 2 * it + h;
        int col, gi;
        if (hh < 10) { col = C_QA + hh * 128; gi = 0; }
        else if (hh < 12) { col = C_KA + (hh - 10) * 128; gi = 1; }
        else if (hh < 22) { col = C_QB + (hh - 12) * 128; gi = 2; }
        else if (hh < 23) { col = C_KB; gi = 3; }
        else if (hh < 35) { col = C_QC + (hh - 23) * 128; gi = 4; }
        else { col = C_KC + (hh - 35) * 128; gi = 5; }
        xa[it] = *(const unsigned*)(P + col + 2 * lp); xb[it] = *(const unsigned*)(P + col + 64 + 2 * lp);
        g1[it] = *(const f32x2*)(gain + gi * 128 + 2 * lp); g2[it] = *(const f32x2*)(gain + gi * 128 + 64 + 2 * lp);
    }
#pragma unroll
    for (int it = 0; it < 5; ++it) {
        const int hh = 4 * it + qd; const int col = (hh < 16) ? C_QI + hh * 64 : C_KI;
        ya[it] = *(const unsigned*)(P + col + 2 * lq); yb[it] = *(const unsigned*)(P + col + 32 + 2 * lq);
    }
    const unsigned vbw = *(const unsigned*)(P + C_VB + 2 * lane);
    const unsigned wiw = (lane < 8) ? *(const unsigned*)(P + C_WI + 2 * lane) : 0u;
    const size_t bt = (size_t)b * T + t;
#pragma unroll
    for (int it = 0; it < 19; ++it) {
        const int hh = 2 * it + h;
        bf16_t* dst; bool isq;
        if (hh < 10) { dst = (bf16_t*)(ws + WS_QA) + ((size_t)(b * 10 + hh) * T + t) * 128; isq = true; }
        else if (hh < 12) { dst = (bf16_t*)(ws + WS_KA) + ((size_t)(b * 2 + (hh - 10)) * T + t) * 128; isq = false; }
        else if (hh < 22) { dst = (bf16_t*)(ws + WS_QB) + (bt * 10 + (hh - 12)) * 128; isq = true; }
        else if (hh < 23) { dst = (bf16_t*)(ws + WS_KB) + bt * 128; isq = false; }
        else if (hh < 35) { const int hc = hh - 23, grp = hc >> 2, sh = 2 * grp, dil = 1 << sh; const int pos = (t & (dil - 1)) * (T >> sh) + (t >> sh);
            dst = (bf16_t*)(ws + WS_QC) + ((size_t)(b * 12 + hc) * T + pos) * 128; isq = true; }
        else { const int grp = hh - 35, sh = 2 * grp, dil = 1 << sh; const int pos = (t & (dil - 1)) * (T >> sh) + (t >> sh);
            dst = (bf16_t*)(ws + WS_KC) + ((size_t)(b * 3 + grp) * T + pos) * 128; isq = false; }
        const unsigned a = xa[it], bq = xb[it];
        const float x1a = bf_lo(a), x1b = bf_hi(a), x2a = bf_lo(bq), x2b = bf_hi(bq);
        float ss = (x1a * x1a + x1b * x1b) + (x2a * x2a + x2b * x2b);
#pragma unroll
        for (int o = 1; o < 32; o <<= 1) ss += __shfl_xor(ss, o);
        const float rstd = __builtin_amdgcn_rsqf(ss * (1.0f / 128.0f) + EPS);
        const float sc = isq ? QSCALE : 1.0f;
        const float y1a = x1a * rstd * g1[it].x, y1b = x1b * rstd * g1[it].y, y2a = x2a * rstd * g2[it].x, y2b = x2b * rstd * g2[it].y;
        const float o1a = (y1a * cs.x - y2a * sn.x) * sc, o1b = (y1b * cs.y - y2b * sn.y) * sc, o2a = (y2a * cs.x + y1a * sn.x) * sc, o2b = (y2b * cs.y + y1b * sn.y) * sc;
        *(unsigned*)(dst + 2 * lp) = pk2(o1a, o1b); *(unsigned*)(dst + 64 + 2 * lp) = pk2(o2a, o2b);
    }
#pragma unroll
    for (int it = 0; it < 5; ++it) {
        const int hh = 4 * it + qd;
        if (hh < 17) {
            bf16_t* dst = (hh < 16) ? (bf16_t*)(ws + WS_QI) + (bt * 16 + hh) * 64 : (bf16_t*)(ws + WS_KI) + bt * 64;
            const unsigned a = ya[it], bq = yb[it];
            const float x1a = bf_lo(a), x1b = bf_hi(a), x2a = bf_lo(bq), x2b = bf_hi(bq);
            *(unsigned*)(dst + 2 * lq) = pk2(x1a * cs6.x - x2a * sn6.x, x1b * cs6.y - x2b * sn6.y); *(unsigned*)(dst + 32 + 2 * lq) = pk2(x2a * cs6.x + x1a * sn6.x, x2b * cs6.y + x1b * sn6.y);
        }
    }
    *(unsigned*)((bf16_t*)(ws + WS_VB) + bt * 128 + 2 * lane) = vbw;
    if (lane < 8) { f32x2 w2 = {bf_lo(wiw), bf_hi(wiw)}; *(f32x2*)((float*)(ws + WS_WI) + bt * 16 + 2 * lane) = w2; }
}
DI void vt_item(const bf16_t* __restrict__ PROJ, bf16_t* __restrict__ VT, int b, int vcol, int dil, int tb, int dc, LAS u32_a* scr, int lane) {
    const int t0 = tb * 128, d0 = dc * 64;
#pragma unroll 4
    for (int i = 0; i < 16; ++i) { const int tt = i * 8 + (lane >> 3), pc = lane & 7;
        const u32x4 v = *(const u32x4*)(PROJ + (size_t)(b * T + t0 + tt) * NPROJ + vcol + d0 + pc * 8);
        scr[tt * 33 + pc * 4 + 0] = v.x; scr[tt * 33 + pc * 4 + 1] = v.y; scr[tt * 33 + pc * 4 + 2] = v.z; scr[tt * 33 + pc * 4 + 3] = v.w; }
    const LAS u16_a* s16 = (const LAS u16_a*)scr;
    const int nchunk = 16 / dil, j = lane & 15, r = j / nchunk, ch = j % nchunk;
    const int pos = r * (T / dil) + t0 / dil + ch * 8;
#pragma unroll 4
    for (int s = 0; s < 16; ++s) {
        const int d = s * 4 + (lane >> 4);
        const LAS u16_a* p = s16 + (r + dil * ch * 8) * 66 + d; const int st = dil * 66;
        u32x4 w;
        w.x = (unsigned)p[0 * st] | ((unsigned)p[1 * st] << 16); w.y = (unsigned)p[2 * st] | ((unsigned)p[3 * st] << 16);
        w.z = (unsigned)p[4 * st] | ((unsigned)p[5 * st] << 16); w.w = (unsigned)p[6 * st] | ((unsigned)p[7 * st] << 16);
        *(u32x4*)(VT + (size_t)(d0 + d) * VTP + pos) = w;
    }
}
DI void p_prep(Frame& F, const float* __restrict__ gain) {
    bf16_t* PROJ = (bf16_t*)(F.ws + WS_PROJ);
    LAS u32_a* scr = (LAS u32_a*)(F.lds + F.wave * 16896);
    for (int it = F.gw; it < NB * 5 * 32 * 2; it += F.ngw) {
        const int dc = it & 1, tb = (it >> 1) & 31, sb = it >> 6, s = sb % 5, b = sb / 5;
        if (s < 2) vt_item(PROJ, (bf16_t*)(F.ws + WS_VTA2) + (size_t)((b * 2 + s) * 128) * VTP, b, C_VA + s * 128, 1, tb, dc, scr, F.lane);
        else { const int g = s - 2; vt_item(PROJ, (bf16_t*)(F.ws + WS_VTC2) + (size_t)((b * 3 + g) * 128) * VTP, b, C_VC + g * 128, g == 0 ? 1 : (g == 1 ? 4 : 16), tb, dc, scr, F.lane); }
    }
    for (int m = F.gw; m < M; m += F.ngw) prep_token(PROJ + (size_t)m * NPROJ, m / T, m % T, gain, F.ws, F.lane);
}
constexpr int BT_WLDS = 18176, BT_KRS = 272, BT_VRS = 336;
static_assert(NWAVES * BT_WLDS <= MISC_OFF && 64 * BT_KRS <= BT_WLDS && 32 * BT_VRS <= BT_WLDS, "band tile LDS map");
template <int MODE, int HP>
DI void band_tile(const bf16_t* __restrict__ qbase, size_t qhs, const bf16_t* __restrict__ kbase, const bf16_t* __restrict__ vt, int L, int W, int q0, float sink2a, float sink2b,
                  bf16_t* __restrict__ oa, bf16_t* __restrict__ oc, float* __restrict__ lse, size_t tok0, int tokstride, int lane, LAS unsigned char* wl) {
    const int n = lane & 15, g = lane >> 4;
    const int k0 = q0 - 128;
    u32x4 kr[12];
#pragma unroll
    for (int i = 0; i < 12; ++i) { int key = k0 + i * 4 + g; key = key < 0 ? 0 : key; kr[i] = *(const u32x4*)(kbase + (size_t)key * 128 + n * 8); }
    bf16x8 qf[HP][4];
    {
        LAS unsigned char* ql = wl + 48 * BT_KRS;
        u32x4 qr[HP][4];
#pragma unroll
        for (int h = 0; h < HP; ++h)
#pragma unroll
            for (int i = 0; i < 4; ++i) qr[h][i] = *(const u32x4*)(qbase + (size_t)h * qhs + (size_t)(q0 + i * 4 + g) * 128 + n * 8);
#pragma unroll
        for (int h = 0; h < HP; ++h) {
#pragma unroll
            for (int i = 0; i < 4; ++i) *(LAS u32x4_a*)(ql + (i * 4 + g) * BT_KRS + n * 16) = qr[h][i];
#pragma unroll
            for (int ks = 0; ks < 4; ++ks) qf[h][ks] = *(const LAS bf16x8_a*)(ql + n * BT_KRS + ks * 64 + g * 16);
        }
    }
    f32x4 s[HP][9];
#pragma unroll
    for (int kg = 0; kg < 3; ++kg) {
#pragma unroll
        for (int i = 0; i < 12; ++i) *(LAS u32x4_a*)(wl + (i * 4 + g) * BT_KRS + n * 16) = kr[i];
        if (kg < 2) {
#pragma unroll
            for (int i = 0; i < 12; ++i) { int key = k0 + (kg + 1) * 48 + i * 4 + g; key = key < 0 ? 0 : key; kr[i] = *(const u32x4*)(kbase + (size_t)key * 128 + n * 8); }
        }
#pragma unroll
        for (int q = 0; q < 3; ++q) {
            f32x4 acc[HP];
#pragma unroll
            for (int h = 0; h < HP; ++h) acc[h] = (f32x4){0.f, 0.f, 0.f, 0.f};
#pragma unroll
            for (int ks = 0; ks < 4; ++ks) { const bf16x8 kf = *(const LAS bf16x8_a*)(wl + (q * 16 + n) * BT_KRS + ks * 64 + g * 16);
#pragma unroll
                for (int h = 0; h < HP; ++h) acc[h] = MFMA16(kf, qf[h][ks], acc[h]); }
#pragma unroll
            for (int h = 0; h < HP; ++h) s[h][kg * 3 + q] = acc[h];
        }
    }
    int voff[10], vlds[10];
#pragma unroll
    for (int j = 0; j < 10; ++j) { const int pi = j * 64 + lane, vrow = pi / 20, vpc = pi - vrow * 20; int pos = k0 + vpc * 8; pos = pos < 0 ? 0 : (pos > L - 8 ? L - 8 : pos);
        voff[j] = vrow * VTP + pos; vlds[j] = vrow * BT_VRS + vpc * 16; }
    u32x4 vr[10];
#pragma unroll
    for (int j = 0; j < 10; ++j) vr[j] = *(const u32x4*)(vt + voff[j]);
    const int qpos = q0 + n;
    const int mlo = (qpos - W + 1) > 0 ? (qpos - W + 1) : 0, mbase = k0 + 4 * g - mlo; const unsigned mspan = (unsigned)(qpos - mlo);
    float inv[HP], mxh[HP], sumh[HP];
    bf16x8 pf[HP][5];
#pragma unroll
    for (int h = 0; h < HP; ++h) {
        const float sink2 = h ? sink2b : sink2a;
        float mx = -INFINITY;
#pragma unroll
        for (int kt = 0; kt < 9; ++kt)
#pragma unroll
            for (int i = 0; i < 4; ++i) { const bool ok = (unsigned)(mbase + kt * 16 + i) <= mspan;
                s[h][kt][i] = ok ? s[h][kt][i] : -INFINITY; mx = fmaxf(mx, s[h][kt][i]); }
        mx = fmaxf(mx, __shfl_xor(mx, 16)); mx = fmaxf(mx, __shfl_xor(mx, 32));
        if (MODE == 0) mx = fmaxf(mx, sink2);
        float sum = 0.f;
#pragma unroll
        for (int kt = 0; kt < 9; ++kt)
#pragma unroll
            for (int i = 0; i < 4; ++i) { const float p = exp2f(s[h][kt][i] - mx); s[h][kt][i] = p; sum += p; }
        sum += __shfl_xor(sum, 16); sum += __shfl_xor(sum, 32);
        if (MODE == 0) sum += exp2f(sink2 - mx);
        inv[h] = 1.0f / sum; mxh[h] = mx; sumh[h] = sum;
#pragma unroll
        for (int jj = 0; jj < 5; ++jj) {
            u32x4 w; w.x = pk2(s[h][2 * jj][0], s[h][2 * jj][1]); w.y = pk2(s[h][2 * jj][2], s[h][2 * jj][3]);
            if (2 * jj + 1 < 9) { w.z = pk2(s[h][2 * jj + 1 < 9 ? 2 * jj + 1 : 0][0], s[h][2 * jj + 1 < 9 ? 2 * jj + 1 : 0][1]); w.w = pk2(s[h][2 * jj + 1 < 9 ? 2 * jj + 1 : 0][2], s[h][2 * jj + 1 < 9 ? 2 * jj + 1 : 0][3]); }
            else { w.z = 0u; w.w = 0u; }
            pf[h][jj] = __builtin_bit_cast(bf16x8, w);
        }
    }
    const size_t tok = tok0 + (size_t)(q0 + n) * tokstride;
    u32x2 ob[HP][8];
#pragma unroll
    for (int dg = 0; dg < 4; ++dg) {
#pragma unroll
        for (int j = 0; j < 10; ++j) *(LAS u32x4_a*)(wl + vlds[j]) = vr[j];
        if (dg < 3) {
#pragma unroll
            for (int j = 0; j < 10; ++j) vr[j] = *(const u32x4*)(vt + (size_t)((dg + 1) * 32) * VTP + voff[j]);
        }
#pragma unroll
        for (int h2 = 0; h2 < 2; ++h2) {
            const int dt = dg * 2 + h2;
            f32x4 o[HP];
#pragma unroll
            for (int h = 0; h < HP; ++h) o[h] = (f32x4){0.f, 0.f, 0.f, 0.f};
#pragma unroll
            for (int jj = 0; jj < 5; ++jj) {
                const LAS unsigned char* vp = wl + (h2 * 16 + n) * BT_VRS + (32 * jj + 4 * g) * 2;
                const u32x2 va = *(const LAS u32x2_a*)vp, vb = *(const LAS u32x2_a*)(vp + 32);
                u32x4 w; w.x = va.x; w.y = va.y; w.z = vb.x; w.w = vb.y;
#pragma unroll
                for (int h = 0; h < HP; ++h) o[h] = MFMA16(__builtin_bit_cast(bf16x8, w), pf[h][jj], o[h]);
            }
#pragma unroll
            for (int h = 0; h < HP; ++h) {
                const f32x4 on = o[h] * inv[h];
                if (MODE == 0) { const f32x4 o8 = on * O8_SCALE; int q8 = 0; q8 = __builtin_amdgcn_cvt_pk_fp8_f32(CL8(o8[0]), CL8(o8[1]), q8, false); q8 = __builtin_amdgcn_cvt_pk_fp8_f32(CL8(o8[2]), CL8(o8[3]), q8, true); ob[h][dt].x = (unsigned)q8; ob[h][dt].y = 0u; }
                else { ob[h][dt].x = pk2(on[0], on[1]); ob[h][dt].y = pk2(on[2], on[3]); }
            }
        }
    }
#pragma unroll
    for (int h = 0; h < HP; ++h) {
        if (MODE == 0) {
#pragma unroll
            for (int dt = 0; dt < 8; ++dt) *(LAS u32_a*)(wl + n * BT_KRS + dt * 16 + 4 * g) = ob[h][dt].x;
#pragma unroll
            for (int i = 0; i < 4; ++i) { const int row = i * 4 + g; const size_t tk = tok0 + (size_t)(q0 + row) * tokstride;
                *(u32x2*)((unsigned char*)oa + tk * 1280 + h * 128 + n * 8) = *(const LAS u32x2_a*)(wl + row * BT_KRS + n * 8); }
        } else {
#pragma unroll
            for (int dt = 0; dt < 8; ++dt) *(LAS u32x2_a*)(wl + n * BT_KRS + (dt * 16 + 4 * g) * 2) = ob[h][dt];
#pragma unroll
            for (int i = 0; i < 4; ++i) { const int row = i * 4 + g; const size_t tk = tok0 + (size_t)(q0 + row) * tokstride;
                *(u32x4*)(oc + tk * 512 + h * 128 + n * 8) = *(const LAS u32x4_a*)(wl + row * BT_KRS + n * 16); }
        }
        if (MODE == 1 && g == 0) lse[tok * 4 + h] = LN2 * (mxh[h] + log2f(sumh[h]));
    }
}
DI void p_attn1(Frame& F, const float* __restrict__ sinks) {
    for (int it = F.gw; it < NB * 2 * 256 * 2; it += F.ngw) {
        const int hp = it & 1; int r = it >> 1; const int qt = r & 255; r >>= 8; const int kvh = r & 1, b = r >> 1;
        const int head = kvh * 5 + hp * 2;
        band_tile<0, 2>((const bf16_t*)(F.ws + WS_QA) + (size_t)(b * 10 + head) * T * 128, (size_t)T * 128, (const bf16_t*)(F.ws + WS_KA) + (size_t)(b * 2 + kvh) * T * 128,
                     (const bf16_t*)(F.ws + WS_VTA2) + (size_t)((b * 2 + kvh) * 128) * VTP, T, 128, qt * 16, sinks[head] * LOG2E, sinks[head + 1] * LOG2E,
                     (bf16_t*)((unsigned char*)(F.ws + WS_OA) + head * 128), nullptr, nullptr, (size_t)b * T, 1, F.lane, F.lds + F.wave * BT_WLDS);
    }
    for (int it = F.gw - F.ngw / 2; it < NB * 2 * 256; it += F.ngw) {
        if (it < 0) continue;
        int r = it; const int qt = r & 255; r >>= 8; const int kvh = r & 1, b = r >> 1;
        const int head = kvh * 5 + 4;
        band_tile<0, 1>((const bf16_t*)(F.ws + WS_QA) + (size_t)(b * 10 + head) * T * 128, 0, (const bf16_t*)(F.ws + WS_KA) + (size_t)(b * 2 + kvh) * T * 128,
                     (const bf16_t*)(F.ws + WS_VTA2) + (size_t)((b * 2 + kvh) * 128) * VTP, T, 128, qt * 16, sinks[head] * LOG2E, 0.f,
                     (bf16_t*)((unsigned char*)(F.ws + WS_OA) + head * 128), nullptr, nullptr, (size_t)b * T, 1, F.lane, F.lds + F.wave * BT_WLDS);
    }
    for (int it = F.gw; it < NB * 3 * 256 * 2; it += F.ngw) {
        const int j = (it & 1) * 2; int r = it >> 1; const int tile = r & 255; r >>= 8; const int grp = r % 3, b = r / 3;
        const int dil = grp == 0 ? 1 : (grp == 1 ? 4 : 16), L = T / dil, tpr = L / 16, res = tile / tpr, qt = tile % tpr;
        band_tile<1, 2>((const bf16_t*)(F.ws + WS_QC) + ((size_t)(b * 12 + grp * 4 + j) * T + (size_t)res * L) * 128, (size_t)T * 128, (const bf16_t*)(F.ws + WS_KC) + ((size_t)(b * 3 + grp) * T + (size_t)res * L) * 128,
                     (const bf16_t*)(F.ws + WS_VTC2) + (size_t)((b * 3 + grp) * 128) * VTP + (size_t)res * L, L, 129, qt * 16, 0.f, 0.f,
                     nullptr, (bf16_t*)(F.ws + WS_OCG) + (size_t)grp * M * 512 + j * 128, (float*)(F.ws + WS_LSE) + (size_t)grp * M * 4 + j, (size_t)b * T + res, dil, F.lane, F.lds + F.wave * BT_WLDS);
    }
}
#ifndef MK_SPDUP
#define MK_SPDUP 0
#endif
#define SPDUP(k) (((MK_SPDUP) >> (k)) & 1)
#ifndef SP_KD
#define SP_KD 3
#endif
#ifndef SP_VD
#define SP_VD 3
#endif
constexpr int KI_RS = 144, KI_BUF = 128 * KI_RS;
constexpr int SP_SEL_OFF = 2 * KI_BUF, SP_V_OFF = SP_SEL_OFF + NWAVES * 1024, SP_V_RS = 272, SP_V_WAVE = 32 * SP_V_RS;
static_assert(SP_V_OFF + NWAVES * SP_V_WAVE <= MISC_OFF, "sparse LDS map");
DI void sparse_block(Frame& F, int b, int t0) {
    int lane = F.lane, tid = F.tid;
    asm volatile("" : "+v"(lane), "+v"(tid));
    const int r = lane & 15, g = lane >> 4;
    const int t = t0 + F.wave, m = b * T + t;
    LAS unsigned char* kibuf = F.lds;
    LAS u32_a* sel = (LAS u32_a*)(F.lds + SP_SEL_OFF) + F.wave * 256;
    LAS unsigned char* vbuf = F.lds + SP_V_OFF + F.wave * SP_V_WAVE;
    const int nch_blk = ((t0 + 7) >> 6) + 1, nch = (t >> 6) + 1;
    const bf16_t* qirow = (const bf16_t*)(F.ws + WS_QI) + ((size_t)m * 16 + r) * 64 + g * 16;
    const bf16x8 qa0 = *(const bf16x8*)qirow, qa1 = *(const bf16x8*)(qirow + 8);
    float wh[4];
    { const f32x4 wv = *(const f32x4*)((const float*)(F.ws + WS_WI) + (size_t)m * 16 + 4 * g); wh[0] = wv[0]; wh[1] = wv[1]; wh[2] = wv[2]; wh[3] = wv[3]; }
    unsigned key[64];
#pragma unroll
    for (int c = 0; c < 64; ++c) key[c] = 0u;
    const bf16_t* kig = (const bf16_t*)(F.ws + WS_KI) + (size_t)(b * T) * 64 + tid * 8;
    const int srow = tid >> 3, spc = tid & 7;
  for (int rp = 0; rp <= SPDUP(0); ++rp) {
    const int nst = (nch_blk + 1) >> 1;
    u32x4 stg[2][2];
    {   const u32x4 s0 = *(const u32x4*)kig, s1 = *(const u32x4*)(kig + 64 * 64);
        stg[1][0] = (u32x4){0u, 0u, 0u, 0u}; stg[1][1] = stg[1][0]; stg[0][0] = stg[1][0]; stg[0][1] = stg[1][0];
        if (1 < nst) { stg[1][0] = *(const u32x4*)(kig + 128 * 64); stg[1][1] = *(const u32x4*)(kig + 192 * 64); }
        *(LAS u32x4_a*)(kibuf + srow * KI_RS + spc * 16) = s0; *(LAS u32x4_a*)(kibuf + (64 + srow) * KI_RS + spc * 16) = s1; }
    __syncthreads();
#pragma unroll
    for (int ps = 0; ps < 32; ++ps) {
      if (ps < nst) {
        if (ps + 2 < nst) { stg[ps & 1][0] = *(const u32x4*)(kig + (ps + 2) * 128 * 64); stg[ps & 1][1] = *(const u32x4*)(kig + (ps + 2) * 128 * 64 + 64 * 64); }
#pragma unroll
        for (int hc = 0; hc < 2; ++hc) {
          const int c = 2 * ps + hc;
          if (c < nch) {
            const LAS unsigned char* kb = kibuf + (ps & 1) * KI_BUF + hc * 64 * KI_RS;
            bf16x8 kb0[4], kb1[4];
#pragma unroll
            for (int j = 0; j < 4; ++j) { kb0[j] = *(const LAS bf16x8_a*)(kb + (j * 16 + r) * KI_RS + g * 32); kb1[j] = *(const LAS bf16x8_a*)(kb + (j * 16 + r) * KI_RS + g * 32 + 16); }
            f32x4 acc[4];
#pragma unroll
            for (int j = 0; j < 4; ++j) acc[j] = MFMA16(qa0, kb0[j], ((f32x4){0.f, 0.f, 0.f, 0.f}));
#pragma unroll
            for (int j = 0; j < 4; ++j) acc[j] = MFMA16(qa1, kb1[j], acc[j]);
            float part[4];
#pragma unroll
            for (int j = 0; j < 4; ++j) {
                float rl[4];
#pragma unroll
                for (int i = 0; i < 4; ++i) { const int bi = (int)__float_as_uint(acc[j][i]); rl[i] = __uint_as_float((unsigned)(bi > 0 ? bi : 0)); }
                part[j] = (wh[0] * rl[0] + wh[1] * rl[1]) + (wh[2] * rl[2] + wh[3] * rl[3]);
            }
            const auto sw0 = __builtin_amdgcn_permlane32_swap(__float_as_uint(part[0]), __float_as_uint(part[2]), false, false);
            const auto sw1 = __builtin_amdgcn_permlane32_swap(__float_as_uint(part[1]), __float_as_uint(part[3]), false, false);
            const float a0 = __uint_as_float(sw0[0]) + __uint_as_float(sw0[1]);
            const float a1 = __uint_as_float(sw1[0]) + __uint_as_float(sw1[1]);
            const bool odd = (g & 1) != 0;
            const float rv = __shfl_xor(odd ? a0 : a1, 16);
            const float sc = (odd ? a1 : a0) + rv;
            const unsigned u = __float_as_uint(sc);
            const unsigned ku = (u & 0x80000000u) ? ~u : (u | 0x80000000u);
            key[c] = (c * 64 + lane <= t) ? ku : 0u;
          }
        }
        if (ps + 1 < nst) { LAS unsigned char* nb = kibuf + ((ps + 1) & 1) * KI_BUF;
            *(LAS u32x4_a*)(nb + srow * KI_RS + spc * 16) = stg[(ps + 1) & 1][0]; *(LAS u32x4_a*)(nb + (64 + srow) * KI_RS + spc * 16) = stg[(ps + 1) & 1][1]; }
        __syncthreads();
      }
    }
  }
    int nsel;
  for (int rp = 0; rp <= SPDUP(1); ++rp) {
    if (t < TOPK) {
        nsel = t + 1;
#pragma unroll
        for (int i = 0; i < 4; ++i) { const int p = i * 64 + lane; sel[p] = (p <= t) ? (unsigned)p : 0u; }
    } else {
        unsigned thr = 0u;
        const int ngrp = (nch + 7) >> 3;
        bool exact = false;
        for (int bit = 31; bit >= 0; --bit) {
            const unsigned cand = thr | (1u << bit);
            int cnt = 0;
#pragma unroll
            for (int gq = 0; gq < 8; ++gq) if (gq < ngrp) {
                unsigned long long mk[8];
#pragma unroll
                for (int j = 0; j < 8; ++j) mk[j] = __ballot(key[gq * 8 + j] >= cand);
#pragma unroll
                for (int j = 0; j < 8; ++j) cnt += __popcll(mk[j]);
            }
            if (cnt >= TOPK) thr = cand;
            if (cnt == TOPK) { exact = true; break; }
        }
        int base = 0;
        if (exact) {
#pragma unroll
            for (int gq = 0; gq < 8; ++gq) if (gq < ngrp) {
#pragma unroll
              for (int j = 0; j < 8; ++j) {
                const int c = gq * 8 + j;
                const bool pred = key[c] >= thr;
                const unsigned long long mp = __ballot(pred);
                const int pos = base + (int)__builtin_amdgcn_mbcnt_hi((unsigned)(mp >> 32), __builtin_amdgcn_mbcnt_lo((unsigned)mp, 0u));
                if (pred) sel[pos] = (unsigned)(c * 64 + lane);
                base += __popcll(mp);
              }
            }
        } else {
        int ngt = 0;
#pragma unroll
        for (int gq = 0; gq < 8; ++gq) if (gq < ngrp) {
#pragma unroll
            for (int j = 0; j < 8; ++j) ngt += __popcll(__ballot(key[gq * 8 + j] > thr));
        }
        const int need = TOPK - ngt;
        int tieb = 0;
#pragma unroll
        for (int gq = 0; gq < 8; ++gq) if (gq < ngrp) {
#pragma unroll
          for (int j = 0; j < 8; ++j) {
            const int c = gq * 8 + j;
            const bool gt = key[c] > thr, eq = key[c] == thr;
            const unsigned long long me = __ballot(eq);
            const int trank = tieb + (int)__builtin_amdgcn_mbcnt_hi((unsigned)(me >> 32), __builtin_amdgcn_mbcnt_lo((unsigned)me, 0u));
            const bool pred = gt || (eq && trank < need);
            const unsigned long long mp = __ballot(pred);
            const int pos = base + (int)__builtin_amdgcn_mbcnt_hi((unsigned)(mp >> 32), __builtin_amdgcn_mbcnt_lo((unsigned)mp, 0u));
            if (pred && pos < TOPK) sel[pos] = (unsigned)(c * 64 + lane);
            base += __popcll(mp); tieb += __popcll(me);
          }
        }
        }
        nsel = base < TOPK ? base : TOPK;
#pragma unroll
        for (int i = 0; i < 4; ++i) { const int p = i * 64 + lane; if (p >= nsel) sel[p] = 0u; }
    }
  }
  for (int rp = 0; rp <= SPDUP(2); ++rp) {
    const int hq = r < 10 ? r : 9;
    bf16x8 qb[4];
#pragma unroll
    for (int ks = 0; ks < 4; ++ks) qb[ks] = *(const bf16x8*)((const bf16_t*)(F.ws + WS_QB) + ((size_t)m * 10 + hq) * 128 + ks * 32 + g * 8);
    const bf16_t* kbg = (const bf16_t*)(F.ws + WS_KB) + (size_t)(b * T) * 128;
    f32x4 sv[16];
    float mx = -INFINITY;
    {
        u32x4 kr[SP_KD][8];
#pragma unroll
        for (int j = 0; j < SP_KD; ++j)
#pragma unroll
            for (int i = 0; i < 8; ++i) { const unsigned idx = sel[32 * j + 4 * i + g]; kr[j][i] = *(const u32x4*)(kbg + (size_t)idx * 128 + r * 8); }
#pragma unroll
        for (int pp = 0; pp < 8; ++pp) {
#pragma unroll
            for (int i = 0; i < 8; ++i) *(LAS u32x4_a*)(vbuf + (4 * i + g) * SP_V_RS + r * 16) = kr[pp % SP_KD][i];
            if (pp + SP_KD < 8) {
#pragma unroll
                for (int i = 0; i < 8; ++i) { const unsigned idx = sel[32 * (pp + SP_KD) + 4 * i + g]; kr[pp % SP_KD][i] = *(const u32x4*)(kbg + (size_t)idx * 128 + r * 8); }
            }
#pragma unroll
            for (int q = 0; q < 2; ++q) {
                f32x4 acc = {0.f, 0.f, 0.f, 0.f};
#pragma unroll
                for (int ks = 0; ks < 4; ++ks) { const bf16x8 kf = *(const LAS bf16x8_a*)(vbuf + (q * 16 + r) * SP_V_RS + ks * 64 + g * 16); acc = MFMA16(kf, qb[ks], acc); }
                sv[2 * pp + q] = acc;
            }
        }
    }
    const int nlim = nsel - 4 * g;
#pragma unroll
    for (int tl = 0; tl < 16; ++tl)
#pragma unroll
        for (int i = 0; i < 4; ++i) { sv[tl][i] = (tl * 16 + i < nlim) ? sv[tl][i] : -INFINITY; mx = fmaxf(mx, sv[tl][i]); }
    mx = fmaxf(mx, __shfl_xor(mx, 16)); mx = fmaxf(mx, __shfl_xor(mx, 32));
    const bf16_t* vbg = (const bf16_t*)(F.ws + WS_VB) + (size_t)(b * T) * 128 + r * 8;
    int psl[8];
#pragma unroll
    for (int i = 0; i < 8; ++i) { const int sr = 4 * i + g, e = sr & 7, gs = sr >> 3; psl[i] = (e < 4) ? 4 * gs + e : 16 + 4 * gs + (e - 4); }
    u32x4 vr[SP_VD][8];
#pragma unroll
    for (int j = 0; j < SP_VD; ++j)
#pragma unroll
        for (int i = 0; i < 8; ++i) { const unsigned idx = sel[32 * j + psl[i]]; vr[j][i] = *(const u32x4*)(vbg + (size_t)idx * 128); }
    float sum = 0.f;
#pragma unroll
    for (int tl = 0; tl < 16; ++tl)
#pragma unroll
        for (int i = 0; i < 4; ++i) { const float p = __builtin_amdgcn_exp2f(sv[tl][i] - mx); sum += p; sv[tl][i] = p; }
    sum += __shfl_xor(sum, 16); sum += __shfl_xor(sum, 32);
    bf16x8 pf[8];
#pragma unroll
    for (int c = 0; c < 8; ++c) { u32x4 w; w.x = pk2(sv[2 * c][0], sv[2 * c][1]); w.y = pk2(sv[2 * c][2], sv[2 * c][3]); w.z = pk2(sv[2 * c + 1][0], sv[2 * c + 1][1]); w.w = pk2(sv[2 * c + 1][2], sv[2 * c + 1][3]);
        pf[c] = __builtin_bit_cast(bf16x8, w); }
    f32x4 o[8];
#pragma unroll
    for (int dt = 0; dt < 8; ++dt) o[dt] = (f32x4){0.f, 0.f, 0.f, 0.f};
    typedef short s16x4 __attribute__((ext_vector_type(4)));
    const LAS unsigned char* trb = vbuf + (g * 8 + (r >> 2)) * SP_V_RS + (r & 3) * 8;
#pragma unroll
    for (int c = 0; c < 8; ++c) {
#pragma unroll
        for (int i = 0; i < 8; ++i) *(LAS u32x4_a*)(vbuf + (4 * i + g) * SP_V_RS + r * 16) = vr[c % SP_VD][i];
        if (c + SP_VD < 8) {
#pragma unroll
            for (int i = 0; i < 8; ++i) { const unsigned idx = sel[32 * (c + SP_VD) + psl[i]]; vr[c % SP_VD][i] = *(const u32x4*)(vbg + (size_t)idx * 128); }
        }
#pragma unroll
        for (int dt = 0; dt < 8; ++dt) {
            const s16x4 t0 = __builtin_amdgcn_ds_read_tr16_b64_v4i16((LAS s16x4*)(trb + dt * 32));
            const s16x4 t1 = __builtin_amdgcn_ds_read_tr16_b64_v4i16((LAS s16x4*)(trb + 4 * SP_V_RS + dt * 32));
            const bf16x8 vf = __builtin_shufflevector(t0, t1, 0, 1, 2, 3, 4, 5, 6, 7);
            o[dt] = MFMA16(pf[c], vf, o[dt]);
        }
    }
    unsigned char* ob = F.ws + WS_OB + (size_t)m * 1280 + r;
#pragma unroll
    for (int i = 0; i < 4; ++i) {
        const int head = 4 * g + i;
        const float sh = __shfl(sum, head < 10 ? head : 0);
        const float inv = 1.0f / sh;
        if (head < 10) {
#pragma unroll
            for (int dt = 0; dt < 8; ++dt) ob[head * 128 + dt * 16] = (unsigned char)(__builtin_amdgcn_cvt_pk_fp8_f32(CL8(o[dt][i] * inv * O8_SCALE), 0.f, 0, false) & 0xff);
        }
    }
  }
}
DI void p_attn2(Frame& F) {
    for (int pi = blockIdx.x; pi < NB * 256; pi += F.G) {
        const int b = pi >> 8, c = pi & 255;
        for (int k2 = 0; k2 < 2; ++k2) sparse_block(F, b, (k2 ? 511 - c : c) * 8);
    }
    const bf16_t* ocg = (const bf16_t*)(F.ws + WS_OCG); const float* lse = (const float*)(F.ws + WS_LSE);
    for (int m = F.gw; m < M; m += F.ngw) {
        const int j = F.lane >> 4, d8 = (F.lane & 15) * 8;
        const float l0 = lse[(size_t)m * 4 + j], l1 = lse[(size_t)(M + m) * 4 + j], l2 = lse[(size_t)(2 * M + m) * 4 + j];
        const float mx = fmaxf(l0, fmaxf(l1, l2));
        float e0 = __expf(l0 - mx), e1 = __expf(l1 - mx), e2 = __expf(l2 - mx);
        const float inv = 1.0f / (e0 + e1 + e2); e0 *= inv; e1 *= inv; e2 *= inv;
        const bf16_t* p0 = ocg + (size_t)m * 512 + j * 128 + d8;
        const u32x4 a = *(const u32x4*)p0, b = *(const u32x4*)(p0 + (size_t)M * 512), c = *(const u32x4*)(p0 + (size_t)2 * M * 512);
        int w8[2] = {0, 0};
#pragma unroll
        for (int q = 0; q < 4; ++q) { const float x0 = (bf_lo(a[q]) * e0 + bf_lo(b[q]) * e1 + bf_lo(c[q]) * e2) * O8_SCALE, x1 = (bf_hi(a[q]) * e0 + bf_hi(b[q]) * e1 + bf_hi(c[q]) * e2) * O8_SCALE;
            if (q & 1) w8[q >> 1] = __builtin_amdgcn_cvt_pk_fp8_f32(CL8(x0), CL8(x1), w8[q >> 1], true); else w8[q >> 1] = __builtin_amdgcn_cvt_pk_fp8_f32(CL8(x0), CL8(x1), w8[q >> 1], false); }
        u32x2 w; w.x = (unsigned)w8[0]; w.y = (unsigned)w8[1];
        *(u32x2*)(F.ws + WS_OC + (size_t)m * 512 + j * 128 + d8) = w;
    }
}

DI void p_fixup(Frame& F, const float* __restrict__ cw) {
    const float* FIX = (const float*)(F.ws + WS_FIX); const bf16_t* HALO = (const bf16_t*)(F.ws + WS_HALO); bf16_t* ACT = (bf16_t*)(F.ws + WS_ACT);
    for (int it = F.gw; it < (M / 256) * (DFF / 128); it += F.ngw) {
        const int pm = it / (DFF / 128), pn = it % (DFF / 128), j = F.lane >> 5, c4 = (F.lane & 31) * 4, ch = pn * 128 + c4;
        const float* fx = FIX + ((size_t)it * 2 + j) * 256 + c4;
        f32x4 cg = *(const f32x4*)fx, cv = *(const f32x4*)(fx + 128);
        if ((pm * 256) % T != 0) {
            const bf16_t* hp = HALO + ((size_t)(it - DFF / 128) * 2) * 256 + c4;
            const u32x2 g0 = *(const u32x2*)hp, v0 = *(const u32x2*)(hp + 128), g1 = *(const u32x2*)(hp + 256), v1 = *(const u32x2*)(hp + 256 + 128);
            f32x4 w0g = *(const f32x4*)(cw + ch), w1g = *(const f32x4*)(cw + NUP + ch), w0v = *(const f32x4*)(cw + DFF + ch), w1v = *(const f32x4*)(cw + NUP + DFF + ch);
#pragma unroll
            for (int q = 0; q < 4; ++q) { w0g[q] = bf_lo(pk2(w0g[q], 0.f)); w1g[q] = bf_lo(pk2(w1g[q], 0.f)); w0v[q] = bf_lo(pk2(w0v[q], 0.f)); w1v[q] = bf_lo(pk2(w1v[q], 0.f)); }
            const f32x4 h0g = {bf_lo(g0.x), bf_hi(g0.x), bf_lo(g0.y), bf_hi(g0.y)}, h1g = {bf_lo(g1.x), bf_hi(g1.x), bf_lo(g1.y), bf_hi(g1.y)};
            const f32x4 h0v = {bf_lo(v0.x), bf_hi(v0.x), bf_lo(v0.y), bf_hi(v0.y)}, h1v = {bf_lo(v1.x), bf_hi(v1.x), bf_lo(v1.y), bf_hi(v1.y)};
            if (j == 0) { cg += w0g * h0g + w1g * h1g; cv += w0v * h0v + w1v * h1v; }
            else { cg += w0g * h1g; cv += w0v * h1v; }
        }
        u32x2 o; o.x = pk2(cg[0] * __builtin_amdgcn_rcpf(1.0f + __expf(-cg[0])) * cv[0], cg[1] * __builtin_amdgcn_rcpf(1.0f + __expf(-cg[1])) * cv[1]); o.y = pk2(cg[2] * __builtin_amdgcn_rcpf(1.0f + __expf(-cg[2])) * cv[2], cg[3] * __builtin_amdgcn_rcpf(1.0f + __expf(-cg[3])) * cv[3]);
        *(u32x2*)(ACT + (size_t)(pm * 256 + j) * DFF + ch) = o;
    }
}

constexpr int N_PHASES = 1 + 11 * DEPTH;
#ifndef GP_ALIGN
#define GP_ALIGN true
#endif
#ifndef GP_SP2
#define GP_SP2 true
#endif
#ifndef MK_PHASE_MASK
#define MK_PHASE_MASK 0xFFF
#endif
#define EN(j) (((MK_PHASE_MASK) >> (j)) & 1)
#ifndef MK_DUP_MASK
#define MK_DUP_MASK 0
#endif
#define DUP(j) (((MK_DUP_MASK) >> (j)) & 1)
#define REPS(j) for (int rep = 0; rep <= DUP(j); ++rep)
#define RSEAM(j) do { if (rep < DUP(j)) { XcdBarrier b2_ = bar; unsigned* p_ = b2_.bar; asm volatile("" : "+s"(p_)); b2_.bar = glob(p_); xcd_barrier(b2_); } } while (0)
struct Args { const float* in[14]; float* out; unsigned char* ws; int ph_lo, ph_hi, li, pad; };
__global__ void __launch_bounds__(NWAVES * 64, 2) mk_fwd(Args args) {
    extern __shared__ __attribute__((aligned(16))) unsigned char lds_raw[];
    Frame F;
    F.lds = (LAS unsigned char*)lds_raw;
    F.tid = threadIdx.x; F.lane = F.tid & 63; F.wave = __builtin_amdgcn_readfirstlane(F.tid >> 6);
    F.G = gridDim.x; F.gw = blockIdx.x * NWAVES + F.wave; F.ngw = F.G * NWAVES; F.ws = glob(args.ws);
    volatile LAS unsigned* MISC = (volatile LAS unsigned*)(F.lds + MISC_OFF);
    if (F.tid < 64) MISC[F.tid] = 0u;
    __syncthreads();
    const int lo = args.ph_lo, hi = args.ph_hi;
    unsigned* ctl = (unsigned*)(glob(args.ws) + WS_CTL);
    XcdBarrier bar; bar.bar = ctl + CW_BAR + args.li * XCD_BAR_WORDS; bar.x = 0u; bar.st = MISC + 8;
    if (hi - lo > 1) bar = xcd_barrier_post(ctl + CW_BAR + args.li * XCD_BAR_WORDS, MISC + 8);
#define IN(k) (lo <= (k) && (k) < hi)
#define LAUNDER() do { int _t = threadIdx.x; asm volatile("" : "+v"(_t)); F.tid = _t; F.lane = _t & 63; unsigned char* _w = args.ws; asm volatile("" : "+s"(_w)); F.ws = glob(_w); F.in = args.in; { int _g = (int)blockIdx.x * NWAVES + F.wave; asm volatile("" : "+s"(_g)); F.gw = _g; } float* _o = args.out; asm volatile("" : "+s"(_o)); F.out = glob(_o); } while (0)
#define SEAM(k) do { if ((k) + 1 < hi) { XcdBarrier b2_ = bar; unsigned* p_ = b2_.bar; asm volatile("" : "+s"(p_)); b2_.bar = glob(p_); xcd_barrier(b2_); } } while (0)
#define H ((bf16_t*)(F.ws + WS_H))
#define PROJ ((bf16_t*)(F.ws + WS_PROJ))
#define Y ((bf16_t*)(F.ws + WS_Y))
#define U ((bf16_t*)(F.ws + WS_U))
#define ACT ((bf16_t*)(F.ws + WS_ACT))
#define SS ((float*)(F.ws + WS_SS))
#define PART ((float*)(F.ws + WS_PART))

    if (EN(0) && IN(0)) { LAUNDER(); REPS(0) { p_prologue(F, F.in); RSEAM(0); } SEAM(0); }

    for (int l = 0; l < DEPTH; ++l) {
        const int pb = 1 + 11 * l;
#define wl (F.ws + WS_W + (size_t)l * LW)
#define xin ((l == 0) ? glob(F.in[0]) : F.out)
        if (EN(1) && IN(pb + 0)) { LAUNDER();
            if (l == 0) { REPS(1) { p_norm(F, xin, glob(F.in[1]), H, F.ws + WS_H8, SS); RSEAM(1); } }
            else p_rowsum(F, PART, SS + (size_t)(2 * l) * M);
            SEAM(pb + 0); }
        if (EN(2) && IN(pb + 1)) { LAUNDER();
            REPS(2) {
                {   pg8::Gemm g{H, (const bf16_t*)(wl + LW_IN), M, NB16, D}; pg8::StaticOrder S; S.init(M, NB16, F.G, (int)blockIdx.x);
                    pg8::EpiStoreBf16 E{PROJ, NPROJ, SS + (size_t)(2 * l) * M, 1.0f / D, EPS, F.lds + pg8::XL_OFF + F.wave * pg8::XL_WAVE, 1.0f};
                    pg8::gemm_phase<pg8::EpiStoreBf16, pg8::StaticOrder, GP_ALIGN, GP_SP2>(F.lds, g, S, E); }
                {   pg8::Gemm g{(const bf16_t*)(F.ws + WS_H8), (const bf16_t*)(F.ws + WS_WG8 + (size_t)l * NG8 * D), M, NG8, D / 2}; pg8::StaticOrder S; S.init(M, NG8, F.G, (int)blockIdx.x);
                    pg8::EpiStoreBf16 E{PROJ + NB16, NPROJ, SS + (size_t)(2 * l) * M, 1.0f / D, EPS, F.lds + pg8::XL_OFF + F.wave * pg8::XL_WAVE, 1.0f / G8_SCALE};
                    pg8::gemm_phase<pg8::EpiStoreBf16, pg8::StaticOrder, GP_ALIGN, GP_SP2, true>(F.lds, g, S, E); }
                if (F.G == 256 && (int)blockIdx.x >= 96) convert_items(F, F.in, l, CV_IN, CV_SPARE_HI, ((int)blockIdx.x - 96) * NWAVES + F.wave, 160 * NWAVES);
                RSEAM(2);
            }
            SEAM(pb + 1);
        }
        if (EN(3) && IN(pb + 2)) { LAUNDER(); p_prep(F, glob(F.in[3]) + (size_t)l * 6 * 128); SEAM(pb + 2); }
        if (EN(4) && IN(pb + 3)) { LAUNDER(); REPS(4) { p_attn1(F, glob(F.in[4]) + (size_t)l * 10); RSEAM(4); } SEAM(pb + 3); }
        if (EN(5) && IN(pb + 4)) { LAUNDER(); REPS(5) { p_attn2(F); RSEAM(5); } SEAM(pb + 4); }
        if (EN(6) && IN(pb + 5)) { LAUNDER();
            REPS(6) for (int br = 0; br < 3; ++br) {
                const bf16_t* A = (const bf16_t*)(F.ws + (br == 0 ? WS_OA : (br == 1 ? WS_OB : WS_OC)));
                const bf16_t* Bt = (const bf16_t*)(wl + (br == 0 ? LW_BRA : (br == 1 ? LW_BRB : LW_BRC)));
                const int K = br == 2 ? KBR_C : KBR_A, gcol = br == 0 ? C_GA : (br == 1 ? C_GB : C_GC);
                pg8::Gemm g{A, Bt, M, D, K / 2}; pg8::StaticOrder S; S.init(M, D, F.G, (int)blockIdx.x);
                pg8::EpiGate E{Y, D, PROJ + gcol, NPROJ, br == 0 ? 1 : 0, F.lds + pg8::XL_OFF + F.wave * pg8::XL_WAVE, 1.0f / (O8_SCALE * WBR8_SCALE), br == 2 ? F.ws + WS_Y8 : nullptr, Y8_SCALE};
                pg8::gemm_phase<pg8::EpiGate, pg8::StaticOrder, GP_ALIGN, GP_SP2, true>(F.lds, g, S, E);
                if (br == 2) RSEAM(6);
            }
            SEAM(pb + 5);
        }
        if (EN(7) && IN(pb + 6)) { LAUNDER();
            pg8::Gemm g{(const bf16_t*)(F.ws + WS_Y8), (const bf16_t*)(wl + LW_OUT), M, D, D / 2}; pg8::StaticOrder S; S.init(M, D, F.G, (int)blockIdx.x);
            REPS(7) { pg8::EpiResid E{xin, (rep < DUP(7)) ? (float*)U : F.out, D, (rep < DUP(7)) ? nullptr : H, glob(F.in[9]) + (size_t)l * D, PART, F.lds + pg8::XL_OFF + F.wave * pg8::XL_WAVE, nullptr, 1.0f / (Y8_SCALE * WOUT8_SCALE)};
            pg8::gemm_phase<pg8::EpiResid, pg8::StaticOrder, GP_ALIGN, GP_SP2, true>(F.lds, g, S, E); RSEAM(7); }
            SEAM(pb + 6);
        }
        if (EN(8) && IN(pb + 7)) { LAUNDER(); p_rowsum(F, PART, SS + (size_t)(2 * l + 1) * M); SEAM(pb + 7); }
        if (EN(9) && IN(pb + 8)) { LAUNDER();
            const int GU = (F.G == 256) ? 251 : F.G;
            pg8::Gemm g{H, (const bf16_t*)(wl + LW_UP), M, NUP, D}; pg8::StaticOrder S; S.init(M, NUP, GU, (int)blockIdx.x);
            pg8::EpiConv E{ACT, SS + (size_t)(2 * l + 1) * M, 1.0f / D, EPS, glob(F.in[11]) + (size_t)l * 3 * NUP, glob(F.in[12]) + (size_t)l * NUP, (float*)(F.ws + WS_FIX), (bf16_t*)(F.ws + WS_HALO), F.lds, F.wave, DFF};
            REPS(9) {
                if ((int)blockIdx.x < GU) pg8::gemm_phase<pg8::EpiConv, pg8::StaticOrder, GP_ALIGN, GP_SP2>(F.lds, g, S, E);
                else if (l + 1 < DEPTH) convert_items(F, F.in, l + 1, CV_SPARE_HI, CV_UP_HI, ((int)blockIdx.x - GU) * NWAVES + F.wave, (F.G - GU) * NWAVES);
                RSEAM(9); }
            SEAM(pb + 8);
        }
        if (EN(10) && IN(pb + 9)) { LAUNDER(); REPS(10) { p_fixup(F, glob(F.in[11]) + (size_t)l * 3 * NUP); RSEAM(10); } SEAM(pb + 9); }
        if (EN(11) && IN(pb + 10)) { LAUNDER();
            pg8::Gemm g{ACT, (const bf16_t*)(wl + LW_DN), M, D, DFF}; pg8::StaticOrder S; S.init(M, D, F.G, (int)blockIdx.x);
            REPS(11) { pg8::EpiResid E{F.out, (rep < DUP(11)) ? (float*)U : F.out, D, (rep < DUP(11) || l + 1 >= DEPTH) ? nullptr : H, glob(F.in[1]) + (size_t)(l + 1 < DEPTH ? l + 1 : 0) * D, PART, F.lds + pg8::XL_OFF + F.wave * pg8::XL_WAVE, (rep < DUP(11) || l + 1 >= DEPTH) ? nullptr : F.ws + WS_H8, 1.0f};
            pg8::gemm_phase<pg8::EpiResid, pg8::StaticOrder, GP_ALIGN, GP_SP2>(F.lds, g, S, E); RSEAM(11); }
            SEAM(pb + 10);
        }
    }
#undef IN
#undef SEAM
#undef H
#undef PROJ
#undef Y
#undef U
#undef ACT
#undef SS
#undef PART
#undef wl
#undef xin
}

extern "C" void kernel_launch(void* const* d_in, const int* in_sizes, int n_in, void* d_out, int out_size, void* d_ws, size_t ws_size, hipStream_t stream) {
    static int grid = 0;
    if (grid == 0) {
        if (n_in != 14 || in_sizes[0] != M * D || out_size != M * D || ws_size < WS_END) {
            fprintf(stderr, "kernel_launch: built for 14 inputs, x/out of %d floats, >= %zu bytes of workspace; got n_in %d, in0 %d, out %d, ws %zu; nothing launched\n", M * D, (size_t)WS_END, n_in, n_in > 0 ? in_sizes[0] : -1, out_size, ws_size);
            grid = -1; return; }
        int dev = 0, cus = 0, per_cu = 0;
        if (hipGetDevice(&dev) != hipSuccess || hipDeviceGetAttribute(&cus, hipDeviceAttributeMultiprocessorCount, dev) != hipSuccess) { fprintf(stderr, "kernel_launch: device query failed\n"); grid = -1; return; }
        if (hipFuncSetAttribute((const void*)mk_fwd, hipFuncAttributeMaxDynamicSharedMemorySize, LDS_BYTES) != hipSuccess) { fprintf(stderr, "kernel_launch: hipFuncSetAttribute failed\n"); grid = -1; return; }
        if (hipOccupancyMaxActiveBlocksPerMultiprocessor(&per_cu, (const void*)mk_fwd, NWAVES * 64, LDS_BYTES) != hipSuccess || per_cu < 1)
            fprintf(stderr, "kernel_launch: note: occupancy query reports %d workgroups per CU\n", per_cu);
        (void)hipGetLastError();
        grid = cus;
    }
    if (grid < 0) return;
    if (hipMemsetAsync((char*)d_ws + WS_CTL, 0, CTL_ZERO_BYTES, stream) != hipSuccess) { fprintf(stderr, "kernel_launch: memset failed\n"); return; }
    Args a{};
    for (int i = 0; i < 14; ++i) a.in[i] = (const float*)d_in[i];
    a.out = (float*)d_out; a.ws = (unsigned char*)d_ws; a.pad = 0;
#if MK_N_LAUNCHES == 1
    a.ph_lo = 0; a.ph_hi = N_PHASES; a.li = 0;
    hipLaunchKernelGGL(mk_fwd, dim3(grid), dim3(NWAVES * 64), LDS_BYTES, stream, a);
#else
    for (int p = 0; p < N_PHASES; ++p) { a.ph_lo = p; a.ph_hi = p + 1; a.li = p; hipLaunchKernelGGL(mk_fwd, dim3(grid), dim3(NWAVES * 64), LDS_BYTES, stream, a); }
#endif
    const hipError_t le = hipPeekAtLastError();
    if (le != hipSuccess) fprintf(stderr, "kernel_launch: launch failed: %s\n", hipGetErrorName(le));
}
```

```cpp
#include <hip/hip_runtime.h>
#include <cstdio>
#include <cstdint>

#ifndef MK_N_LAUNCHES
#define MK_N_LAUNCHES 1
#endif

#define DI __device__ __forceinline__
#define GAS __attribute__((address_space(1)))
template <class T> __device__ __forceinline__ T* glob(T* p) { return (T*)(GAS T*)(unsigned long long)p; }
#define LAS __attribute__((address_space(3)))
typedef unsigned short bf16_t;
typedef short bf16x8 __attribute__((ext_vector_type(8)));
typedef float f32x4 __attribute__((ext_vector_type(4)));
typedef float f32x2 __attribute__((ext_vector_type(2)));
typedef unsigned u32x4 __attribute__((ext_vector_type(4)));
typedef unsigned u32x2 __attribute__((ext_vector_type(2)));
typedef __bf16 nbf16x2 __attribute__((ext_vector_type(2)));
typedef bf16x8 __attribute__((may_alias)) bf16x8_a;
typedef u32x4 __attribute__((may_alias)) u32x4_a;
typedef u32x2 __attribute__((may_alias)) u32x2_a;
typedef unsigned __attribute__((may_alias)) u32_a;
typedef unsigned short __attribute__((may_alias)) u16_a;

DI unsigned pk2(float lo, float hi) { f32x2 v = {lo, hi}; nbf16x2 r = __builtin_convertvector(v, nbf16x2); return __builtin_bit_cast(unsigned, r); }
#define CL8(x) __builtin_amdgcn_fmed3f((x), -448.0f, 448.0f)
DI float bf_lo(unsigned u) { return __uint_as_float(u << 16); }
DI float bf_hi(unsigned u) { return __uint_as_float(u & 0xffff0000u); }
DI float bf1(bf16_t h) { return __uint_as_float(((unsigned)h) << 16); }
DI float wave_sum(float v) {
#pragma unroll
    for (int o = 1; o < 64; o <<= 1) v += __shfl_xor(v, o);
    return v;
}
#define MFMA16(a, b, c) __builtin_amdgcn_mfma_f32_16x16x32_bf16((a), (b), (c), 0, 0, 0)

constexpr int NB = 2, T = 4096, D = 4096, M = NB * T, DEPTH = 2;
constexpr int N_IN = 19024, NPROJ = 19200;
constexpr int C_QI = 0, C_KI = 1024, C_WI = 1088, C_KA = 1104, C_KB = 1360, C_KC = 1488,   C_VA = 2048, C_VB = 2304, C_VC = 2432,
              C_QA = 2816, C_QB = 4096, C_QC = 5376, C_GA = 6912, C_GB = 11008, C_GC = 15104;
DI int proj_col(int n) {
    return n < 1280 ? C_QA + n : n < 1536 ? C_KA + (n - 1280) : n < 1792 ? C_VA + (n - 1536) : n < 3072 ? C_QB + (n - 1792) : n < 3200 ? C_KB + (n - 3072) : n < 3328 ? C_VB + (n - 3200)
         : n < 4432 ? n - 3328 : n < 5968 ? C_QC + (n - 4432) : n < 6352 ? C_KC + (n - 5968) : n < 6736 ? C_VC + (n - 6352) : C_GA + (n - 6736);
}
constexpr int DFF = 11008, NUP = 2 * DFF;
#ifndef MK_UP_P
#define MK_UP_P 64
#endif
constexpr int UP_P = MK_UP_P;
constexpr int NB16 = 2048, NG8 = NPROJ - NB16;
constexpr float G8_SCALE = 64.0f;
constexpr float O8_SCALE = 16.0f, WBR8_SCALE = 32.0f, Y8_SCALE = 16.0f, WOUT8_SCALE = 64.0f, WUP8_SCALE = 64.0f;
constexpr int KBR_A = 1280, KBR_B = 1280, KBR_C = 512;
constexpr float EPS = 1e-6f;
constexpr float LOG2E = 1.4426950408889634f, LN2 = 0.6931471805599453f;
constexpr float QSCALE = 0.08838834764831845f * LOG2E;
constexpr int TOPK = 256;
constexpr int VTP = T + 64;

constexpr size_t MiB = 1u << 20;
constexpr size_t WS_CTL = 0, CTL_ZERO_BYTES = 1 * MiB;
constexpr size_t WS_COS128 = 2 * MiB, WS_SIN128 = 3 * MiB, WS_COS64 = 4 * MiB, WS_SIN64 = 4 * MiB + 512 * 1024;
constexpr size_t WS_W = 8 * MiB, LW = 464 * MiB;
constexpr size_t LW_IN = 0, LW_BRA = 150 * MiB, LW_BRB = 160 * MiB, LW_BRC = 170 * MiB, LW_OUT = 174 * MiB, LW_UP = 206 * MiB, LW_DN = 378 * MiB;
constexpr size_t WS_H = 936 * MiB, WS_PROJ = 1000 * MiB, WS_VTA = 1300 * MiB, WS_VTC = 1304 * MiB, WS_OCG = 1310 * MiB, WS_LSE = 1358 * MiB,
                 WS_OA = 1359 * MiB, WS_OB = 1379 * MiB, WS_OC = 1399 * MiB, WS_Y = 1407 * MiB, WS_U = 1471 * MiB, WS_ACT = 1815 * MiB, WS_PART = 1987 * MiB  ,
                 WS_QA = 1990 * MiB  , WS_KA = 2010 * MiB  , WS_QB = 2014 * MiB  , WS_KB = 2034 * MiB  , WS_VB = 2036 * MiB,
                 WS_QI = 2038 * MiB  , WS_KI = 2054 * MiB  , WS_WI = 2055 * MiB  , WS_QC = 2056 * MiB  , WS_KC = 2080 * MiB  ,
                 WS_VTA2 = 2086 * MiB  , WS_VTC2 = 2091 * MiB  ,
                 WS_FIX = 2098 * MiB  , WS_HALO = 2104 * MiB  ,
                 WS_H8 = 2107 * MiB  , WS_WG8 = 2139 * MiB  ,
                 WS_Y8 = 2279 * MiB  , WS_END = 2311 * MiB;
static_assert(WS_WG8 + (size_t)DEPTH * NG8 * D <= WS_Y8, "fp8 in-proj weights");
static_assert((size_t)NPROJ * D * 2 == 150 * MiB && (size_t)NUP * D * 2 == 172 * MiB && (size_t)D * DFF * 2 == 86 * MiB && (size_t)M * NPROJ * 2 == 300 * MiB, "ws map");
static_assert((size_t)M * NUP * 2 == 344 * MiB && (size_t)M * DFF * 2 == 172 * MiB && (size_t)3 * M * 512 * 4 == 48 * MiB, "ws map");
constexpr size_t WS_SS = 512 * 1024;
constexpr int CW_BAR = 4096;

constexpr int LDS_BYTES = 163840;
constexpr int MISC_OFF = LDS_BYTES - 256;
constexpr int NWAVES = 8;
static __device__ const float INV128[64] = {1.0f, 0.865964353f, 0.749894261f, 0.649381638f, 0.562341332f, 0.486967534f, 0.421696514f, 0.365174115f, 0.316227764f, 0.273841977f, 0.237137377f, 0.2053525f, 0.177827939f, 0.153992653f, 0.133352131f, 0.115478203f, 0.100000001f, 0.0865964293f, 0.0749894157f, 0.0649381652f, 0.0562341325f, 0.0486967526f, 0.0421696529f, 0.0365174115f, 0.0316227749f, 0.0273841973f, 0.0237137377f, 0.0205352511f, 0.0177827943f, 0.0153992651f, 0.0133352149f, 0.0115478206f, 0.00999999978f, 0.00865964312f, 0.00749894185f, 0.00649381615f, 0.00562341325f, 0.00486967526f, 0.00421696482f, 0.00365174119f, 0.00316227763f, 0.00273841969f, 0.00237137359f, 0.00205352483f, 0.00177827943f, 0.00153992651f, 0.00133352145f, 0.0011547819f, 0.00100000005f, 0.000865964335f, 0.000749894243f, 0.000649381662f, 0.000562341302f, 0.000486967532f, 0.000421696517f, 0.000365174143f, 0.000316227757f, 0.000273841957f, 0.00023713737f, 0.00020535251f, 0.00017782794f, 0.000153992645f, 0.00013335215f, 0.0001154782f};
static __device__ const float INV64[32] = {1.0f, 0.749894261f, 0.562341332f, 0.421696514f, 0.316227764f, 0.237137377f, 0.177827939f, 0.133352131f, 0.100000001f, 0.0749894157f, 0.0562341325f, 0.0421696529f, 0.0316227749f, 0.0237137377f, 0.0177827943f, 0.0133352149f, 0.00999999978f, 0.00749894185f, 0.00562341325f, 0.00421696482f, 0.00316227763f, 0.00237137359f, 0.00177827943f, 0.00133352145f, 0.00100000005f, 0.000749894243f, 0.000562341302f, 0.000421696517f, 0.000316227757f, 0.00023713737f, 0.00017782794f, 0.00013335215f};

#ifndef PG8_WGM
#define PG8_WGM 8
#endif
namespace pg8 {
#define PG8_LAS __attribute__((address_space(3)))
typedef unsigned short bf16_t;
typedef short bf16x8 __attribute__((ext_vector_type(8)));
typedef float f32x4 __attribute__((ext_vector_type(4)));
typedef unsigned u32x4 __attribute__((ext_vector_type(4)));
constexpr int BM = 256, BK = 64, HALF = 128, HTB = HALF * BK * 2  , STAGE_BYTES = 8 * HTB, NXCD = 8, WGM = PG8_WGM;

__host__ __device__ __forceinline__ int lds_byte(int r, int c) { const int st = (r >> 4) * 2 + (c >> 5), rr = r & 15, cc = c & 31, ob = rr * 64 + cc * 2; return st * 1024 + (ob ^ (((ob >> 9) & 1) << 5)); }
__host__ __device__ __forceinline__ void stage_rc(int b, int& R, int& C) { const int st = b / 1024, sb = b % 1024, swz = sb ^ (((sb >> 9) & 1) << 5); R = (st >> 1) * 16 + swz / 64; C = (st & 1) * 32 + (swz % 64) / 2; }
__host__ __device__ __forceinline__ int perm32(int rho) { const int n = rho >> 4, i = rho & 15; return 8 * (i >> 2) + 4 * n + (i & 3); }

struct Unit { int pm, pn; };
struct Gemm { const bf16_t* A; const bf16_t* Bt; int M, N, K; };

struct StaticOrder {
    int nM, nN, nwg, G, c;
    __host__ __device__ void init(int M, int N, int G_, int c_) { nM = M / BM; nN = N / BM; nwg = nM * nN; G = G_; c = c_; }
    __host__ __device__ bool next(int i, Unit& u) const {
        const long L = (long)i * G + c; if (L >= nwg) return false;
        int wgid = (int)L; { const int q = nwg / NXCD, r = nwg % NXCD, xcd = wgid % NXCD, off = wgid / NXCD; wgid = (xcd < r ? xcd * (q + 1) : r * (q + 1) + (xcd - r) * q) + off; }
        const int nig = WGM * nN, gid = wgid / nig, fm = gid * WGM, gsz = (nM - fm) < WGM ? (nM - fm) : WGM;
        u.pm = fm + ((wgid % nig) % gsz); u.pn = (wgid % nig) / gsz; return true;
    }
    __device__ __forceinline__ void a_ready(const Unit&) const {}
    __device__ __forceinline__ void done(const Unit&) const {}
};

#define PG8_GAS __attribute__((address_space(1)))
constexpr int XL_OFF = 131072, XL_WAVE = 3040, XL_BUF = 1520, XL_RS = 80;
struct EpiStoreBf16 {
    static constexpr bool PERM = true, AFTER_DRAIN = false;
    bf16_t* O; int ldc; const float* ss; float inv_k, eps; PG8_LAS unsigned char* xl; float mul;
    __device__ __forceinline__ void operator()(const f32x4 (&acc)[2][2][4][2], const Unit& u, int wr, int wc, int fr_, int fq_) const {
        int fr = fr_, fq = fq_; asm volatile("" : "+v"(fr), "+v"(fq));
        const int rowb = u.pm * BM + wr * 64, colb = u.pn * BM + wc * 32, lr = fq * 4 + (fr >> 2), lp = fr & 3;
        float rsl[2];
        { const PG8_GAS float* sp = (const PG8_GAS float*)ss + rowb + (fq * 16 + fr); const float s0 = sp[0], s1 = sp[HALF];
          rsl[0] = mul / sqrtf(s0 * inv_k + eps); rsl[1] = mul / sqrtf(s1 * inv_k + eps); }
#pragma unroll
        for (int ai = 0; ai < 2; ++ai)
#pragma unroll
            for (int m = 0; m < 4; ++m) { const int rb = rowb + ai * HALF + m * 16;
                const float rs = __shfl(rsl[ai], m * 16 + fr);
#pragma unroll
                for (int bj = 0; bj < 2; ++bj) { const f32x4 v0 = acc[ai][bj][m][0] * rs, v1 = acc[ai][bj][m][1] * rs;
                    PG8_LAS unsigned char* buf = xl + bj * XL_BUF;
                    u32x4 w; w.x = pk2(v0[0], v0[1]); w.y = pk2(v0[2], v0[3]); w.z = pk2(v1[0], v1[1]); w.w = pk2(v1[2], v1[3]);
                    *(PG8_LAS u32x4*)(buf + fr * XL_RS + fq * 16) = w;
                    const u32x4 t = *(const PG8_LAS u32x4*)(buf + lr * XL_RS + lp * 16);
                    *(u32x4*)(O + (size_t)(rb + lr) * ldc + colb + bj * HALF + lp * 8) = t; } }
    }
};
struct EpiGate {
    static constexpr bool PERM = true, AFTER_DRAIN = false;
    bf16_t* Y; int ldy; const bf16_t* G; int ldg; int first; PG8_LAS unsigned char* xl; float mul; unsigned char* Y8; float y8s;
    __device__ __forceinline__ void operator()(const f32x4 (&acc)[2][2][4][2], const Unit& u, int wr, int wc, int fr_, int fq_) const {
        int fr = fr_, fq = fq_; asm volatile("" : "+v"(fr), "+v"(fq));
        const int rowb = u.pm * BM + wr * 64, colb = u.pn * BM + wc * 32, lr = fq * 4 + (fr >> 2), lp = fr & 3;
        u32x4 gvb[2][2], yvb[2][2];
#define EG_LOAD(k_) do { const size_t row_ = (size_t)(rowb + ((k_) >> 2) * HALF + ((k_) & 3) * 16 + lr); _Pragma("unroll") for (int bj = 0; bj < 2; ++bj) { \
            gvb[(k_) & 1][bj] = *(const u32x4*)(G + row_ * ldg + colb + bj * HALF + lp * 8); \
            yvb[(k_) & 1][bj] = (u32x4){0u, 0u, 0u, 0u}; if (!first) yvb[(k_) & 1][bj] = *(const u32x4*)(Y + row_ * ldy + colb + bj * HALF + lp * 8); } } while (0)
        EG_LOAD(0);
#pragma unroll
        for (int k = 0; k < 8; ++k) { const int ai = k >> 2, m = k & 3; const size_t row = (size_t)(rowb + ai * HALF + m * 16 + lr);
                if (k < 7) EG_LOAD(k + 1);
                const u32x4 (&gv)[2] = gvb[k & 1]; const u32x4 (&yv)[2] = yvb[k & 1];
#pragma unroll
                for (int bj = 0; bj < 2; ++bj) { const f32x4 v0 = acc[ai][bj][m][0], v1 = acc[ai][bj][m][1];
                    PG8_LAS unsigned char* buf = xl + bj * XL_BUF;
                    u32x4 w; w.x = pk2(v0[0], v0[1]); w.y = pk2(v0[2], v0[3]); w.z = pk2(v1[0], v1[1]); w.w = pk2(v1[2], v1[3]);
                    *(PG8_LAS u32x4*)(buf + fr * XL_RS + fq * 16) = w;
                    const u32x4 t = *(const PG8_LAS u32x4*)(buf + lr * XL_RS + lp * 16);
                    u32x4 o; int yq[2] = {0, 0};
#pragma unroll
                    for (int q = 0; q < 4; ++q) { const unsigned gw = gv[bj][q], yw = yv[bj][q], aw = t[q];
                        const float s0 = __builtin_amdgcn_rcpf(1.0f + __expf(-bf_lo(gw))), s1 = __builtin_amdgcn_rcpf(1.0f + __expf(-bf_hi(gw)));
                        const float y0 = bf_lo(yw) + s0 * mul * bf_lo(aw), y1 = bf_hi(yw) + s1 * mul * bf_hi(aw);
                        o[q] = pk2(y0, y1); if (q & 1) yq[q >> 1] = __builtin_amdgcn_cvt_pk_fp8_f32(CL8(y0 * y8s), CL8(y1 * y8s), yq[q >> 1], true); else yq[q >> 1] = __builtin_amdgcn_cvt_pk_fp8_f32(CL8(y0 * y8s), CL8(y1 * y8s), yq[q >> 1], false); }
                    *(u32x4*)(Y + row * ldy + colb + bj * HALF + lp * 8) = o;
                    if (Y8) { u32x2 w8; w8.x = (unsigned)yq[0]; w8.y = (unsigned)yq[1]; *(u32x2*)(Y8 + row * ldy + colb + bj * HALF + lp * 8) = w8; } } }
#undef EG_LOAD
    }
};
struct EpiResid {
    static constexpr bool PERM = false, AFTER_DRAIN = false;
    const float* R; float* O; int ldc; bf16_t* Hn; const float* gn; float* ssn; PG8_LAS unsigned char* xl; unsigned char* H8n; float mul;
    __device__ __forceinline__ void operator()(const f32x4 (&acc)[2][2][4][2], const Unit& u, int wr, int wc, int fr_, int fq_) const {
        int fr = fr_, fq = fq_; asm volatile("" : "+v"(fr), "+v"(fq));
        const int rowb = u.pm * BM + wr * 64, colb = u.pn * BM + wc * 32, lr = fq * 4 + (fr >> 2), lp = fr & 3;
        f32x4 gv[2][2];
#pragma unroll
        for (int bj = 0; bj < 2; ++bj)
#pragma unroll
            for (int n = 0; n < 2; ++n) gv[bj][n] = Hn ? *(const f32x4*)(gn + colb + bj * HALF + n * 16 + lp * 4) : (f32x4){0.f, 0.f, 0.f, 0.f};
        f32x4 rvb[2][2][2];
#define ER_LOAD(k_) do { const size_t off_ = (size_t)(rowb + ((k_) >> 2) * HALF + ((k_) & 3) * 16 + lr) * ldc + colb + lp * 4; _Pragma("unroll") for (int bj = 0; bj < 2; ++bj) _Pragma("unroll") for (int n = 0; n < 2; ++n) \
            rvb[(k_) & 1][bj][n] = *(const f32x4*)(R + off_ + bj * HALF + n * 16); } while (0)
        ER_LOAD(0);
#pragma unroll
        for (int k = 0; k < 8; ++k) { const int ai = k >> 2, m = k & 3; const int row = rowb + ai * HALF + m * 16 + lr; const size_t off = (size_t)row * ldc + colb + lp * 4;
                if (k < 7) ER_LOAD(k + 1);
                const f32x4 (&rv)[2][2] = rvb[k & 1];
                float sq = 0.f;
#pragma unroll
                for (int bj = 0; bj < 2; ++bj)
#pragma unroll
                    for (int n = 0; n < 2; ++n) {
                        PG8_LAS unsigned char* buf = xl + n * XL_BUF;
                        *(PG8_LAS f32x4*)(buf + fr * XL_RS + fq * 16) = acc[ai][bj][m][n];
                        const f32x4 t = *(const PG8_LAS f32x4*)(buf + lr * XL_RS + lp * 16);
                        const f32x4 x = rv[bj][n] + t * mul; *(f32x4*)(O + off + bj * HALF + n * 16) = x;
                        if (Hn) { sq += (x[0] * x[0] + x[1] * x[1]) + (x[2] * x[2] + x[3] * x[3]); const f32x4 y = x * gv[bj][n];
                            u32x2 w; w.x = pk2(y[0], y[1]); w.y = pk2(y[2], y[3]); *(u32x2*)(Hn + off + bj * HALF + n * 16) = w;
                            if (H8n) { int q8 = 0; q8 = __builtin_amdgcn_cvt_pk_fp8_f32(CL8(y[0]), CL8(y[1]), q8, false); q8 = __builtin_amdgcn_cvt_pk_fp8_f32(CL8(y[2]), CL8(y[3]), q8, true); *(unsigned*)(H8n + off + bj * HALF + n * 16) = (unsigned)q8; } } }
                if (Hn) { sq += __shfl_xor(sq, 1); sq += __shfl_xor(sq, 2);
                    if (lp == 0) ssn[(size_t)row * 64 + u.pn * 4 + wc] = sq; } }
#undef ER_LOAD
    }
};
typedef __bf16 nbf2 __attribute__((ext_vector_type(2)));
#define DOT2(a, b, c) __builtin_amdgcn_fdot2_f32_bf16(__builtin_bit_cast(nbf2, (unsigned)(a)), __builtin_bit_cast(nbf2, (unsigned)(b)), (c), false)
constexpr int XCH_OFF = XL_OFF + 8 * XL_WAVE, XCH_SLOT = 256;
struct EpiConv {
    static constexpr bool PERM = true, AFTER_DRAIN = false;
    bf16_t* ACT; const float* ss; float inv_k, eps; const float* cw; const float* cb; float* FIX; bf16_t* HALO; PG8_LAS unsigned char* lds0; int wid, dff; float mul; int pn0;
    __device__ __forceinline__ void operator()(const f32x4 (&acc)[2][2][4][2], const Unit& u, int wr, int wc, int fr_, int fq_) const {
        int fr = fr_, fq = fq_; asm volatile("" : "+v"(fr), "+v"(fq));
        const int rowb = u.pm * BM + wr * 64, lr = fq * 4 + (fr >> 2), lp = fr & 3, nup = 2 * dff;
        PG8_LAS unsigned char* xl = lds0 + XL_OFF + wid * XL_WAVE;
        PG8_LAS unsigned char* xch = lds0 + XCH_OFF;
        const int upn = u.pn + pn0;
        const int ch0 = upn * 128 + wc * 32 + lp * 8;
        f32x4 wraw;
        { const int j = lr, hf = j >> 3, kind = (j >> 1) & 3, part = j & 1;
          const float* src = (kind < 3 ? cw + (size_t)kind * nup : cb) + hf * dff + ch0 + part * 4; wraw = *(const f32x4*)src; }
        float rsl[2];
        { const PG8_GAS float* sp = (const PG8_GAS float*)ss + rowb + (fq * 16 + fr); const float s0 = sp[0], s1 = sp[HALF];
          rsl[0] = mul / sqrtf(s0 * inv_k + eps); rsl[1] = mul / sqrtf(s1 * inv_k + eps); }
#pragma unroll
        for (int ai = 0; ai < 2; ++ai) { const float rs = __shfl(rsl[ai], 48 + fr);
#pragma unroll
            for (int bj = 0; bj < 2; ++bj) { const f32x4 v0 = acc[ai][bj][3][0] * rs, v1 = acc[ai][bj][3][1] * rs;
                u32x4 w; w.x = pk2(v0[0], v0[1]); w.y = pk2(v0[2], v0[3]); w.z = pk2(v1[0], v1[1]); w.w = pk2(v1[2], v1[3]);
                if (fr >= 14) *(PG8_LAS u32x4*)(xch + ((ai * 2 + wr) * 4 + wc) * XCH_SLOT + bj * 128 + (fr - 14) * 64 + fq * 16) = w; } }
        asm volatile("s_waitcnt lgkmcnt(0)" ::: "memory"); __builtin_amdgcn_s_barrier(); asm volatile("" ::: "memory");
        PG8_LAS unsigned char* wlds = xch + 16 * XCH_SLOT + wid * 512 + lp * 128;
        {
            *(PG8_LAS f32x4*)(xl + (lr * 4 + lp) * 16) = wraw;
            if (lr == 0) {
#pragma unroll
                for (int hf = 0; hf < 2; ++hf) {
#pragma unroll
                    for (int pr = 0; pr < 2; ++pr) {
                        f32x4 t[4];
#pragma unroll
                        for (int k = 0; k < 4; ++k) t[k] = *(const PG8_LAS f32x4*)(xl + ((hf * 8 + pr * 4 + k) * 4 + lp) * 16);
                        u32x4 x0, x1;
#pragma unroll
                        for (int q = 0; q < 4; ++q) { x0[q] = pk2(t[0][q], t[2][q]); x1[q] = pk2(t[1][q], t[3][q]); }
                        *(PG8_LAS u32x4*)(wlds + hf * 64 + pr * 32) = x0; *(PG8_LAS u32x4*)(wlds + hf * 64 + pr * 32 + 16) = x1; }
                }
            }
        }
        const size_t tile = (size_t)u.pm * (dff / 128) + upn;
#pragma unroll
        for (int ai = 0; ai < 2; ++ai) {
            if (lr < 2) { u32x4 cg = {0u, 0u, 0u, 0u}, cv = {0u, 0u, 0u, 0u};
                if (wr == 1 || ai == 1) { const int ps = wr == 1 ? (ai * 2 + 0) * 4 + wc : (0 * 2 + 1) * 4 + wc;
                    cg = *(const PG8_LAS u32x4*)(xch + ps * XCH_SLOT + lr * 64 + lp * 16); cv = *(const PG8_LAS u32x4*)(xch + ps * XCH_SLOT + 128 + lr * 64 + lp * 16); }
                *(PG8_LAS u32x4*)(xl + lr * XL_RS + lp * 16) = cg; *(PG8_LAS u32x4*)(xl + XL_BUF + lr * XL_RS + lp * 16) = cv; }
#pragma unroll
            for (int m = 0; m < 4; ++m) { const int rb = rowb + ai * HALF + m * 16;
                const float rs = __shfl(rsl[ai], m * 16 + fr);
#pragma unroll
                for (int bj = 0; bj < 2; ++bj) { const f32x4 v0 = acc[ai][bj][m][0] * rs, v1 = acc[ai][bj][m][1] * rs;
                    u32x4 w; w.x = pk2(v0[0], v0[1]); w.y = pk2(v0[2], v0[3]); w.z = pk2(v1[0], v1[1]); w.w = pk2(v1[2], v1[3]);
                    *(PG8_LAS u32x4*)(xl + bj * XL_BUF + (2 + fr) * XL_RS + fq * 16) = w; }
                const bool top = (ai == 0) && (m == 0) && (wr == 0) && (lr < 2);
                const bool bot = (ai == 1) && (m == 3) && (wr == 1) && (lr >= 14);
                float sg[8];
                int wo = 0; asm volatile("" : "+v"(wo));
                {   u32x4 g[3], wa[2], wb[2];
#pragma unroll
                    for (int k = 0; k < 2; ++k) { wa[k] = *(const PG8_LAS u32x4*)(wlds + wo + k * 16); wb[k] = *(const PG8_LAS u32x4*)(wlds + wo + 32 + k * 16); }
#pragma unroll
                    for (int k = 0; k < 3; ++k) g[k] = *(const PG8_LAS u32x4*)(xl + (lr + k) * XL_RS + lp * 16);
                    if (lr >= 14) { *(PG8_LAS u32x4*)(xl + (lr - 14) * XL_RS + lp * 16) = g[2];
                        if (bot) { int l2 = lr, p2 = lp; asm volatile("" : "+v"(l2), "+v"(p2)); const int ho = (l2 - 14) * 256 + wc * 32 + p2 * 8; *(u32x4*)(HALO + tile * 512 + ho) = g[2]; } }
#pragma unroll
                    for (int q = 0; q < 4; ++q) {
                        const unsigned a_lo = __builtin_amdgcn_perm(g[1][q], g[0][q], 0x05040100u), a_hi = __builtin_amdgcn_perm(g[1][q], g[0][q], 0x07060302u);
                        const unsigned b_lo = __builtin_amdgcn_perm(0x3f803f80u, g[2][q], 0x05040100u), b_hi = __builtin_amdgcn_perm(0x3f803f80u, g[2][q], 0x07060302u);
                        sg[2 * q] = DOT2(b_lo, wb[q >> 1][(2 * q) & 3], DOT2(a_lo, wa[q >> 1][(2 * q) & 3], 0.f));
                        sg[2 * q + 1] = DOT2(b_hi, wb[q >> 1][(2 * q + 1) & 3], DOT2(a_hi, wa[q >> 1][(2 * q + 1) & 3], 0.f)); }
                    if (top) { int l2 = lr, p2 = lp; asm volatile("" : "+v"(l2), "+v"(p2)); const int fo = l2 * 256 + wc * 32 + p2 * 8; float* fx = FIX + tile * 512 + fo;
                        *(f32x4*)(fx) = (f32x4){sg[0], sg[1], sg[2], sg[3]}; *(f32x4*)(fx + 4) = (f32x4){sg[4], sg[5], sg[6], sg[7]}; }
#pragma unroll
                    for (int q = 0; q < 8; ++q) sg[q] = sg[q] * __builtin_amdgcn_rcpf(1.0f + __expf(-sg[q])); }
                {   u32x4 v[3], wa[2], wb[2];
#pragma unroll
                    for (int k = 0; k < 2; ++k) { wa[k] = *(const PG8_LAS u32x4*)(wlds + wo + 64 + k * 16); wb[k] = *(const PG8_LAS u32x4*)(wlds + wo + 96 + k * 16); }
#pragma unroll
                    for (int k = 0; k < 3; ++k) v[k] = *(const PG8_LAS u32x4*)(xl + XL_BUF + (lr + k) * XL_RS + lp * 16);
                    if (lr >= 14) { *(PG8_LAS u32x4*)(xl + XL_BUF + (lr - 14) * XL_RS + lp * 16) = v[2];
                        if (bot) { int l2 = lr, p2 = lp; asm volatile("" : "+v"(l2), "+v"(p2)); const int ho = (l2 - 14) * 256 + 128 + wc * 32 + p2 * 8; *(u32x4*)(HALO + tile * 512 + ho) = v[2]; } }
                    float cv[8];
#pragma unroll
                    for (int q = 0; q < 4; ++q) {
                        const unsigned a_lo = __builtin_amdgcn_perm(v[1][q], v[0][q], 0x05040100u), a_hi = __builtin_amdgcn_perm(v[1][q], v[0][q], 0x07060302u);
                        const unsigned b_lo = __builtin_amdgcn_perm(0x3f803f80u, v[2][q], 0x05040100u), b_hi = __builtin_amdgcn_perm(0x3f803f80u, v[2][q], 0x07060302u);
                        cv[2 * q] = DOT2(b_lo, wb[q >> 1][(2 * q) & 3], DOT2(a_lo, wa[q >> 1][(2 * q) & 3], 0.f));
                        cv[2 * q + 1] = DOT2(b_hi, wb[q >> 1][(2 * q + 1) & 3], DOT2(a_hi, wa[q >> 1][(2 * q + 1) & 3], 0.f)); }
                    if (top) { int l2 = lr, p2 = lp; asm volatile("" : "+v"(l2), "+v"(p2)); const int fo = l2 * 256 + 128 + wc * 32 + p2 * 8; float* fx = FIX + tile * 512 + fo;
                        *(f32x4*)(fx) = (f32x4){cv[0], cv[1], cv[2], cv[3]}; *(f32x4*)(fx + 4) = (f32x4){cv[4], cv[5], cv[6], cv[7]}; }
                    else { u32x4 o;
#pragma unroll
                        for (int q = 0; q < 4; ++q) o[q] = pk2(sg[2 * q] * cv[2 * q], sg[2 * q + 1] * cv[2 * q + 1]);
                        *(u32x4*)(ACT + (size_t)(rb + lr) * dff + ch0) = o; } }
            }
        }
    }
};

template <class Epi, class Sched, bool ALIGN_EPI = false, bool SP2 = false, bool FP8 = false>
__device__ __forceinline__ void gemm_phase(PG8_LAS unsigned char* lds, const Gemm g, const Sched& S, const Epi& E) {
    int tid_ = threadIdx.x; asm volatile("" : "+v"(tid_));
    const int tid = tid_, wid = __builtin_amdgcn_readfirstlane(tid >> 6), lane = tid & 63, wr = wid >> 2, wc = wid & 3, fr = lane & 15, fq = lane >> 4;
    const int K = g.K, nt = K / BK;
    unsigned voffA[2], voffB[2];
#pragma unroll
    for (int i = 0; i < 2; ++i) { int R, C; stage_rc(tid * 16 + i * 8192, R, C); const int Rb = Epi::PERM ? ((R & ~31) + perm32(R & 31)) : R;
        voffA[i] = (unsigned)(R * K + C) * 2u; voffB[i] = (unsigned)(Rb * K + C) * 2u; }
    const size_t kstep = (size_t)(BK * 2);
    const size_t hstep = (size_t)HALF * K * 2;
    const size_t tstep = 2 * hstep;
    const unsigned ldsw = (unsigned)wid * 1024u;
    const int aoff = lds_byte(wr * 64 + fr, fq * 8), boff = lds_byte(wc * 32 + fr, fq * 8);
#define PG8_SA(b, h) (((b) * 2 + (h)) * HTB)
#define PG8_SB(b, h) ((4 + (b) * 2 + (h)) * HTB)
#define PG8_STAGE(bufoff, gbase, voff) do { _Pragma("unroll") for (int _i = 0; _i < 2; ++_i) \
        __builtin_amdgcn_global_load_lds((const unsigned*)((const char*)(gbase) + (voff)[_i]), (PG8_LAS unsigned*)(lds + (bufoff) + ldsw + _i * 8192), 16, 0, 0); } while (0)
#define PG8_LDA(dst, b, h) do { _Pragma("unroll") for (int m = 0; m < 4; ++m) { if constexpr (FP8) { \
        const v4i_ lo_ = *(const PG8_LAS v4i_*)(lds + PG8_SA(b, h) + aoff + m * 2048), hi_ = *(const PG8_LAS v4i_*)(lds + PG8_SA(b, h) + aoff + m * 2048 + 1024); dst##8[m] = __builtin_shufflevector(lo_, hi_, 0, 1, 2, 3, 4, 5, 6, 7); } \
        else { _Pragma("unroll") for (int k = 0; k < 2; ++k) dst[m][k] = *(const PG8_LAS bf16x8*)(lds + PG8_SA(b, h) + aoff + m * 2048 + k * 1024); } } } while (0)
#define PG8_LDB(dst, b, h) do { _Pragma("unroll") for (int n = 0; n < 2; ++n) { if constexpr (FP8) { \
        const v4i_ lo_ = *(const PG8_LAS v4i_*)(lds + PG8_SB(b, h) + boff + n * 2048), hi_ = *(const PG8_LAS v4i_*)(lds + PG8_SB(b, h) + boff + n * 2048 + 1024); dst##8[n] = __builtin_shufflevector(lo_, hi_, 0, 1, 2, 3, 4, 5, 6, 7); } \
        else { _Pragma("unroll") for (int k = 0; k < 2; ++k) dst[n][k] = *(const PG8_LAS bf16x8*)(lds + PG8_SB(b, h) + boff + n * 2048 + k * 1024); } } } while (0)
#define PG8_MMA(ai, bj, At, Bt) do { __builtin_amdgcn_s_setprio(1); _Pragma("unroll") for (int m = 0; m < 4; ++m) _Pragma("unroll") for (int n = 0; n < 2; ++n) { \
        if constexpr (FP8) asm volatile("v_mfma_f32_16x16x128_f8f6f4 %0, %1, %2, %0" : "+v"(acc[ai][bj][m][n]) : "v"(Bt##8[n]), "v"(At##8[m]));     \
        else { _Pragma("unroll") for (int k = 0; k < 2; ++k) acc[ai][bj][m][n] = __builtin_amdgcn_mfma_f32_16x16x32_bf16(Bt[n][k], At[m][k], acc[ai][bj][m][n], 0, 0, 0); } } \
        __builtin_amdgcn_s_setprio(0); } while (0)
#define PG8_WAIT_V(n) asm volatile("s_waitcnt vmcnt(" #n ")" ::: "memory")
#define PG8_WAIT_L(n) asm volatile("s_waitcnt lgkmcnt(" #n ")" ::: "memory")
#define PG8_BAR __builtin_amdgcn_s_barrier()
#define PG8_SCHED __builtin_amdgcn_sched_barrier(0)
    Unit cur, nxt; int ui = 0;
    if (!S.next(0, cur)) return;
    f32x4 acc[2][2][4][2];
#pragma unroll
    for (int a = 0; a < 2; ++a)
#pragma unroll
        for (int b = 0; b < 2; ++b)
#pragma unroll
            for (int m = 0; m < 4; ++m)
#pragma unroll
                for (int n = 0; n < 2; ++n) acc[a][b][m][n] = (f32x4){0.f, 0.f, 0.f, 0.f};
    typedef int v4i_ __attribute__((ext_vector_type(4))); typedef int v8i_ __attribute__((ext_vector_type(8)));
    bf16x8 At[4][2], B0[2][2], B1[2][2]; v8i_ At8[4], B08[2], B18[2];
    const char* cA = (const char*)g.A + (size_t)cur.pm * tstep; const char* cB = (const char*)g.Bt + (size_t)cur.pn * tstep;
    S.a_ready(cur);
    if constexpr (SP2) {
        PG8_STAGE(PG8_SB(0, 0), cB, voffB); PG8_STAGE(PG8_SB(0, 1), cB + hstep, voffB); PG8_STAGE(PG8_SA(0, 0), cA, voffA); PG8_STAGE(PG8_SA(0, 1), cA + hstep, voffA);
        if (wr == 1) PG8_BAR;
        PG8_WAIT_V(2); PG8_BAR;
        PG8_STAGE(PG8_SB(1, 0), cB + kstep, voffB); PG8_STAGE(PG8_SA(1, 0), cA + kstep, voffA); PG8_STAGE(PG8_SB(1, 1), cB + hstep + kstep, voffB);
        PG8_WAIT_V(6); PG8_BAR;
    } else {
        PG8_STAGE(PG8_SB(0, 0), cB, voffB); PG8_STAGE(PG8_SA(0, 0), cA, voffA); PG8_STAGE(PG8_SB(0, 1), cB + hstep, voffB); PG8_STAGE(PG8_SA(0, 1), cA + hstep, voffA);
        if (wr == 1) PG8_BAR;
        PG8_WAIT_V(4); PG8_BAR;
        PG8_STAGE(PG8_SB(1, 0), cB + kstep, voffB); PG8_STAGE(PG8_SA(1, 0), cA + kstep, voffA); PG8_STAGE(PG8_SB(1, 1), cB + hstep + kstep, voffB);
        PG8_WAIT_V(6); PG8_BAR;
    }
    for (;;) {
        const bool has_next = S.next(ui + 1, nxt);
        const char* nA = has_next ? (const char*)g.A + (size_t)nxt.pm * tstep : cA; const char* nB = has_next ? (const char*)g.Bt + (size_t)nxt.pn * tstep : cB;
        for (int t = 0; t < nt; t += 2) {
            const bool last = (t == nt - 2);
            const char* a1 = cA + (size_t)(t + 1) * kstep;
            const char* a2 = last ? nA : cA + (size_t)(t + 2) * kstep; const char* b2 = last ? nB : cB + (size_t)(t + 2) * kstep;
            const char* a3 = a2 + kstep; const char* b3 = b2 + kstep;
            if (last && has_next) S.a_ready(nxt);
            if constexpr (SP2) {
            PG8_LDB(B0, 0, 0); PG8_LDB(B1, 0, 1); PG8_SCHED; PG8_LDA(At, 0, 0); PG8_STAGE(PG8_SA(1, 1), a1 + hstep, voffA);
            PG8_WAIT_V(8); PG8_WAIT_L(0); PG8_BAR; PG8_MMA(0, 0, At, B0); PG8_MMA(0, 1, At, B1); PG8_BAR; PG8_SCHED;
            PG8_LDA(At, 0, 1); PG8_STAGE(PG8_SB(0, 0), b2, voffB); PG8_STAGE(PG8_SB(0, 1), b2 + hstep, voffB); PG8_STAGE(PG8_SA(0, 0), a2, voffA);
            PG8_WAIT_V(8); PG8_WAIT_L(0); PG8_BAR; PG8_MMA(1, 0, At, B0); PG8_MMA(1, 1, At, B1); PG8_BAR; PG8_SCHED;
            PG8_LDB(B0, 1, 0); PG8_LDB(B1, 1, 1); PG8_SCHED; PG8_LDA(At, 1, 0); PG8_STAGE(PG8_SA(0, 1), a2 + hstep, voffA);
            PG8_WAIT_V(8); PG8_WAIT_L(0); PG8_BAR; PG8_MMA(0, 0, At, B0); PG8_MMA(0, 1, At, B1); PG8_BAR; PG8_SCHED;
            PG8_LDA(At, 1, 1); PG8_STAGE(PG8_SB(1, 0), b3, voffB); PG8_STAGE(PG8_SB(1, 1), b3 + hstep, voffB); PG8_STAGE(PG8_SA(1, 0), a3, voffA);
            PG8_WAIT_V(8); PG8_WAIT_L(0); PG8_BAR; PG8_MMA(1, 0, At, B0); PG8_MMA(1, 1, At, B1); PG8_BAR; PG8_SCHED;
            } else {
            PG8_LDB(B0, 0, 0); PG8_SCHED; PG8_LDA(At, 0, 0); PG8_STAGE(PG8_SA(1, 1), a1 + hstep, voffA);
            PG8_WAIT_L(8); PG8_BAR; PG8_WAIT_L(0); PG8_MMA(0, 0, At, B0); PG8_BAR; PG8_SCHED;
            PG8_LDB(B1, 0, 1); PG8_STAGE(PG8_SB(0, 0), b2, voffB);
            PG8_BAR; PG8_WAIT_L(0); PG8_MMA(0, 1, At, B1); PG8_BAR;
            PG8_LDA(At, 0, 1); PG8_STAGE(PG8_SA(0, 0), a2, voffA);
            PG8_BAR; PG8_WAIT_L(0); PG8_MMA(1, 0, At, B0); PG8_BAR; PG8_SCHED;
            PG8_STAGE(PG8_SB(0, 1), b2 + hstep, voffB);
            PG8_WAIT_V(6); PG8_BAR; PG8_MMA(1, 1, At, B1); PG8_BAR;
            PG8_LDB(B0, 1, 0); PG8_SCHED; PG8_LDA(At, 1, 0); PG8_STAGE(PG8_SA(0, 1), a2 + hstep, voffA);
            PG8_WAIT_L(8); PG8_BAR; PG8_WAIT_L(0); PG8_MMA(0, 0, At, B0); PG8_BAR; PG8_SCHED;
            PG8_LDB(B1, 1, 1); PG8_STAGE(PG8_SB(1, 0), b3, voffB);
            PG8_BAR; PG8_WAIT_L(0); PG8_MMA(0, 1, At, B1); PG8_BAR;
            PG8_LDA(At, 1, 1); PG8_STAGE(PG8_SA(1, 0), a3, voffA);
            PG8_BAR; PG8_WAIT_L(0); PG8_MMA(1, 0, At, B0); PG8_BAR; PG8_SCHED;
            PG8_STAGE(PG8_SB(1, 1), b3 + hstep, voffB);
            PG8_WAIT_V(6); PG8_BAR; PG8_MMA(1, 1, At, B1); PG8_BAR;
            }
        }
        if constexpr (ALIGN_EPI) { if (wr == 0) PG8_BAR; }
        if constexpr (!Epi::AFTER_DRAIN) { E(acc, cur, wr, wc, fr, fq); S.done(cur); }
        if (!has_next) break;
#pragma unroll
        for (int a = 0; a < 2; ++a)
#pragma unroll
            for (int b = 0; b < 2; ++b)
#pragma unroll
                for (int m = 0; m < 4; ++m)
#pragma unroll
                    for (int n = 0; n < 2; ++n) acc[a][b][m][n] = (f32x4){0.f, 0.f, 0.f, 0.f};
        cur = nxt; cA = nA; cB = nB; ++ui;
        if constexpr (ALIGN_EPI) { if (wr == 1) PG8_BAR; }
    }
    PG8_WAIT_V(0);
    if constexpr (!ALIGN_EPI) { if (wr == 0) PG8_BAR; }
    PG8_BAR;
    if constexpr (Epi::AFTER_DRAIN) { E.fused(acc, cur, wr, wc, fr, fq, lds, wid, lane); S.done(cur); }
#undef PG8_SA
#undef PG8_SB
#undef PG8_STAGE
#undef PG8_LDA
#undef PG8_LDB
#undef PG8_MMA
#undef PG8_WAIT_V
#undef PG8_WAIT_L
#undef PG8_BAR
#undef PG8_SCHED
}
}

#define XB_TMO      128
#define XB_XCNT(j)  (256  + 64 * (j))
#define XB_XSUB(j)  (1280 + 64 * (j))
#define XB_XGEN(j)  (2304 + 64 * (j))
#define XB_TOP      3328
#define XB_TOPGEN   3392
#define XCD_BAR_WORDS 3456
#define XB_SPIN_CAP (1u << 18)

__device__ __forceinline__ unsigned xb_ld(unsigned* p)              { return __hip_atomic_load(p, __ATOMIC_RELAXED, __HIP_MEMORY_SCOPE_AGENT); }
__device__ __forceinline__ unsigned xb_add(unsigned* p, unsigned v) { return __hip_atomic_fetch_add(p, v, __ATOMIC_RELAXED, __HIP_MEMORY_SCOPE_AGENT); }
__device__ __forceinline__ unsigned xb_xcc_id() { return (unsigned)__builtin_amdgcn_s_getreg((3 << 11) | 20) & 0xFu; }
#define XB_SPIN(cond, bar) do { unsigned _sp = 0; while (cond) { __builtin_amdgcn_s_sleep(1); \
    if ((++_sp & 255u) == 0u) { if (xb_ld(&(bar)[XB_TMO])) break; if (_sp > XB_SPIN_CAP) { atomicAdd(&(bar)[XB_TMO], 1u); break; } } } } while (0)

struct XcdBarrier {
    unsigned* bar; unsigned x;
    volatile LAS unsigned* st;
};

__device__ __forceinline__ XcdBarrier xcd_barrier_post(unsigned* bar, volatile LAS unsigned* st) {
    XcdBarrier b; b.bar = bar; b.x = xb_xcc_id(); b.st = st;
    if (threadIdx.x == 0) (void)xb_add(&bar[XB_XCNT(b.x)], 1u);
    return b;
}
__device__ __forceinline__ void xcd_barrier_complete(unsigned* bar, unsigned x, unsigned& nloc, unsigned& nx) {
    const unsigned G = gridDim.x * gridDim.y * gridDim.z;
    unsigned sum, cnt, mine, sp = 0u;
    for (;;) {
        sum = 0u; cnt = 0u; mine = 0u;
#pragma unroll
        for (unsigned j = 0; j < 16; ++j) { const unsigned c = xb_ld(&bar[XB_XCNT(j)]); sum += c; cnt += (c > 0u) ? 1u : 0u; mine = (j == x) ? c : mine; }
        if (sum == G) break;
        __builtin_amdgcn_s_sleep(1);
        if ((++sp & 255u) == 0u) { if (xb_ld(&bar[XB_TMO])) break; if (sp > XB_SPIN_CAP) { atomicAdd(&bar[XB_TMO], 1u); break; } }
    }
    nloc = mine > 0u ? mine : 1u; nx = cnt > 0u ? cnt : 1u;
}

__device__ __forceinline__ void xcd_barrier(const XcdBarrier& b) {
    asm volatile("s_waitcnt vmcnt(0)" ::: "memory");
    __syncthreads();
    if (threadIdx.x == 0) {
        unsigned* bar = b.bar;
        __builtin_amdgcn_s_waitcnt(0);
        unsigned nloc = b.st[0], nx = b.st[1];
        if (nloc == 0u) { xcd_barrier_complete(bar, b.x, nloc, nx); b.st[0] = nloc; b.st[1] = nx; }
        const unsigned old = xb_add(&bar[XB_XSUB(b.x)], 1u);
        const unsigned gen = old / nloc;
        if (old + 1u == (gen + 1u) * nloc) {
            __builtin_amdgcn_fence(__ATOMIC_RELEASE, "agent");
            asm volatile("s_waitcnt vmcnt(0)" ::: "memory");
            const unsigned og = xb_add(&bar[XB_TOP], 1u);
            const unsigned tg = og / nx;
            if (og + 1u == (tg + 1u) * nx) xb_add(&bar[XB_TOPGEN], 1u);
            else XB_SPIN(xb_ld(&bar[XB_TOPGEN]) == tg, bar);
            __builtin_amdgcn_fence(__ATOMIC_ACQUIRE, "agent");
            xb_add(&bar[XB_XGEN(b.x)], 1u);
            asm volatile("s_waitcnt vmcnt(0)" ::: "memory");
        } else {
            XB_SPIN(xb_ld(&bar[XB_XGEN(b.x)]) == gen, bar);
            __builtin_amdgcn_fence(__ATOMIC_ACQUIRE, "agent");
            asm volatile("s_waitcnt vmcnt(0)" ::: "memory");
        }
    }
    __syncthreads();
}

struct Frame {
    LAS unsigned char* lds;
    int tid, lane, wave, G, gw, ngw;
    unsigned char* ws;
    const float* const* in; float* out;
};

struct CvItem { const float* W; bf16_t* WT; unsigned char* W8; float sc8; int K, N, k0, n0, nd0; };
constexpr int CV_IN = 32 * 298, CV_BA = 10 * 64, CV_BC = 4 * 64, CV_OUT = 32 * 64, CV_UP = 32 * 344, CV_DN = 86 * 64;
constexpr int CV_PER_LAYER = CV_IN + 2 * CV_BA + CV_BC + CV_OUT + CV_UP + CV_DN;
#ifndef MK_CV_SPARE
#define MK_CV_SPARE 2000
#endif
constexpr int CV_SPARE_HI = CV_IN + MK_CV_SPARE;
#ifndef MK_CV_UP
#define MK_CV_UP 2000
#endif
constexpr int CV_UP_HI = CV_SPARE_HI + MK_CV_UP;
DI CvItem cv_decode(const float* const* in, unsigned char* wl, unsigned char* ws8, int l, int it) {
    int r = it; CvItem c;
    c.W8 = nullptr; c.sc8 = 1.0f;
    if (r < CV_IN) { c.W = glob(in[2]) + (size_t)l * D * N_IN; c.WT = (bf16_t*)(wl + LW_IN); c.K = D; c.N = N_IN; c.k0 = (r / 298) * 128; c.n0 = (r % 298) * 64; c.nd0 = c.n0;
        c.W8 = ws8 + (size_t)l * NG8 * D; c.sc8 = G8_SCALE; c.nd0 = -1; return c; }     r -= CV_IN;
    if (r < CV_BA) { c.W = glob(in[5]) + (size_t)l * KBR_A * D; c.WT = nullptr; c.W8 = wl + LW_BRA; c.sc8 = WBR8_SCALE; c.K = KBR_A; c.N = D; c.k0 = (r / 64) * 128; c.n0 = (r % 64) * 64; c.nd0 = c.n0; return c; } r -= CV_BA;
    if (r < CV_BA) { c.W = glob(in[6]) + (size_t)l * KBR_B * D; c.WT = nullptr; c.W8 = wl + LW_BRB; c.sc8 = WBR8_SCALE; c.K = KBR_B; c.N = D; c.k0 = (r / 64) * 128; c.n0 = (r % 64) * 64; c.nd0 = c.n0; return c; } r -= CV_BA;
    if (r < CV_BC) { c.W = glob(in[7]) + (size_t)l * KBR_C * D; c.WT = nullptr; c.W8 = wl + LW_BRC; c.sc8 = WBR8_SCALE; c.K = KBR_C; c.N = D; c.k0 = (r / 64) * 128; c.n0 = (r % 64) * 64; c.nd0 = c.n0; return c; } r -= CV_BC;
    if (r < CV_OUT) { c.W = glob(in[8]) + (size_t)l * D * D; c.WT = nullptr; c.W8 = wl + LW_OUT; c.sc8 = WOUT8_SCALE; c.K = D; c.N = D; c.k0 = (r / 64) * 128; c.n0 = (r % 64) * 64; c.nd0 = c.n0; return c; } r -= CV_OUT;
    if (r < CV_UP) { c.W = glob(in[10]) + (size_t)l * D * NUP; c.WT = (bf16_t*)(wl + LW_UP); c.K = D; c.N = NUP; c.k0 = (r / 344) * 128; c.n0 = (r % 344) * 64; { const int half = c.n0 >= DFF, ch = c.n0 - half * DFF; c.nd0 = 256 * (ch >> 7) + 128 * half + (ch & 127);
            if ((ch >> 7) >= UP_P) { c.WT = nullptr; c.W8 = wl + LW_UP + (size_t)UP_P * 256 * D * 2; c.sc8 = WUP8_SCALE; c.nd0 -= UP_P * 256; } }
        return c; } r -= CV_UP;
    c.W = glob(in[13]) + (size_t)l * DFF * D; c.WT = (bf16_t*)(wl + LW_DN); c.K = DFF; c.N = D; c.k0 = (r / 64) * 128; c.n0 = (r % 64) * 64; c.nd0 = c.n0; return c;
}
DI void cv_load(f32x4 (&v)[32], const CvItem& c, int lane) {
    const int r4 = lane >> 4, c4 = (lane & 15) * 4; const bool colok = (c.n0 + c4) < c.N;
    const float* p = c.W + (size_t)(c.k0 + r4) * c.N + c.n0 + c4;
#pragma unroll
    for (int i = 0; i < 32; ++i) v[i] = colok ? *(const f32x4*)(p + (size_t)(4 * i) * c.N) : (f32x4){0.f, 0.f, 0.f, 0.f};
}
DI void convert_items(Frame& F, const float* const* in, int l, int lo, int hi, int widx, int nw) {
    LAS u32_a* scr = (LAS u32_a*)(F.lds + F.wave * 16896);
    const LAS u16_a* s16 = (const LAS u16_a*)scr;
    unsigned char* wl = F.ws + WS_W + (size_t)l * LW;
    const int lane = F.lane, r4 = lane >> 4;
    int it = lo + widx;
    if (it >= hi) return;
    f32x4 v[32];
    unsigned char* ws8 = F.ws + WS_WG8;
    CvItem cur = cv_decode(in, wl, ws8, l, it);
    cv_load(v, cur, lane);
    for (;;) {
#pragma unroll
        for (int i = 0; i < 32; ++i) { const int k = i * 4 + r4; scr[k * 33 + (lane & 15) * 2] = pk2(v[i].x, v[i].y); scr[k * 33 + (lane & 15) * 2 + 1] = pk2(v[i].z, v[i].w); }
        const int nx = it + nw; const bool more = nx < hi;
        CvItem nxt = cur;
        if (more) { nxt = cv_decode(in, wl, ws8, l, nx); cv_load(v, nxt, lane); }
#pragma unroll 4
        for (int s = 0; s < 16; ++s) {
            const int n = (s >> 2) * 16 + (lane & 15), c = (s & 3) * 4 + (lane >> 4);
            const LAS u16_a* p = s16 + (8 * c) * 66 + n;
            u32x4 w;
            w.x = (unsigned)p[0 * 66] | ((unsigned)p[1 * 66] << 16); w.y = (unsigned)p[2 * 66] | ((unsigned)p[3 * 66] << 16);
            w.z = (unsigned)p[4 * 66] | ((unsigned)p[5 * 66] << 16); w.w = (unsigned)p[6 * 66] | ((unsigned)p[7 * 66] << 16);
            if (cur.n0 + n < cur.N) {
                int drow = cur.nd0 + n; bool to8 = cur.W8 != nullptr;
                if (cur.nd0 < 0) { const int pc = proj_col(cur.n0 + n); to8 = pc >= NB16; drow = to8 ? pc - NB16 : pc; }
                if (to8) { int lo = 0, hi = 0;
                    lo = __builtin_amdgcn_cvt_pk_fp8_f32(CL8(bf_lo(w.x) * cur.sc8), CL8(bf_hi(w.x) * cur.sc8), lo, false); lo = __builtin_amdgcn_cvt_pk_fp8_f32(CL8(bf_lo(w.y) * cur.sc8), CL8(bf_hi(w.y) * cur.sc8), lo, true);
                    hi = __builtin_amdgcn_cvt_pk_fp8_f32(CL8(bf_lo(w.z) * cur.sc8), CL8(bf_hi(w.z) * cur.sc8), hi, false); hi = __builtin_amdgcn_cvt_pk_fp8_f32(CL8(bf_lo(w.w) * cur.sc8), CL8(bf_hi(w.w) * cur.sc8), hi, true);
                    u32x2 w8; w8.x = (unsigned)lo; w8.y = (unsigned)hi; *(u32x2*)(cur.W8 + (size_t)drow * cur.K + cur.k0 + 8 * c) = w8; }
                else *(u32x4*)(cur.WT + (size_t)drow * cur.K + cur.k0 + 8 * c) = w; }
        }
        if (!more) break;
        cur = nxt; it = nx;
    }
}
DI void p_prologue(Frame& F, const float* const* in) {
    if (F.G == 256) {
        for (int l = 0; l < DEPTH; ++l) { convert_items(F, in, l, 0, CV_IN, F.gw, F.ngw); convert_items(F, in, l, l == 0 ? CV_SPARE_HI : CV_UP_HI, CV_PER_LAYER, F.gw, F.ngw); } }
    else { for (int l = 0; l < DEPTH; ++l) convert_items(F, in, l, 0, CV_PER_LAYER, F.gw, F.ngw); }
    for (int it = F.gw; it < DEPTH * 176; it += F.ngw) {
        const int l = it / 176, rr = 1872 + it % 176;
        u32x4* p = (u32x4*)(F.ws + WS_W + (size_t)l * LW + LW_IN + (size_t)rr * D * 2) + F.lane;
#pragma unroll
        for (int j = 0; j < 8; ++j) p[64 * j] = (u32x4){0u, 0u, 0u, 0u};
    }
    for (int t = F.gw; t < T; t += F.ngw) {
        const int i = F.lane;
        { const float inv = INV128[i]; const float ang = (float)t * inv; float sn, cs; sincosf(ang, &sn, &cs);
          ((float*)(F.ws + WS_COS128))[t * 64 + i] = cs; ((float*)(F.ws + WS_SIN128))[t * 64 + i] = sn; }
        if (i < 32) { const float inv = INV64[i]; const float ang = (float)t * inv; float sn, cs; sincosf(ang, &sn, &cs);
          ((float*)(F.ws + WS_COS64))[t * 32 + i] = cs; ((float*)(F.ws + WS_SIN64))[t * 32 + i] = sn; }
    }
}

DI void p_norm(Frame& F, const float* __restrict__ x, const float* __restrict__ g, bf16_t* __restrict__ H, unsigned char* __restrict__ H8, float* __restrict__ ss) {
    for (int m = F.gw; m < M; m += F.ngw) {
        const f32x4* xr = (const f32x4*)(x + (size_t)m * D) + F.lane;
        f32x4 v[16]; float sq = 0.f;
#pragma unroll
        for (int j = 0; j < 16; ++j) { v[j] = xr[64 * j]; sq += (v[j].x * v[j].x + v[j].y * v[j].y) + (v[j].z * v[j].z + v[j].w * v[j].w); }
        sq = wave_sum(sq);
        if (F.lane == 0) ss[m] = sq;
        u32x2* o = (u32x2*)(H + (size_t)m * D) + F.lane;
#pragma unroll
        for (int j = 0; j < 16; ++j) { const f32x4 gg = ((const f32x4*)g)[64 * j + F.lane];
            u32x2 w; w.x = pk2(v[j].x * gg.x, v[j].y * gg.y); w.y = pk2(v[j].z * gg.z, v[j].w * gg.w); o[64 * j] = w;
            int q8 = 0; q8 = __builtin_amdgcn_cvt_pk_fp8_f32(CL8(v[j].x * gg.x), CL8(v[j].y * gg.y), q8, false); q8 = __builtin_amdgcn_cvt_pk_fp8_f32(CL8(v[j].z * gg.z), CL8(v[j].w * gg.w), q8, true);
            ((unsigned*)(H8 + (size_t)m * D))[64 * j + F.lane] = (unsigned)q8; }
    }
}

DI void p_rowsum(Frame& F, const float* __restrict__ part, float* __restrict__ ss) {
    for (int m = F.gw; m < M; m += F.ngw) { const float s = wave_sum(part[(size_t)m * 64 + F.lane]); if (F.lane == 0) ss[m] = s; }
}

DI void prep_token(const bf16_t* __restrict__ P, int b, int t, const float* __restrict__ gain, unsigned char* __restrict__ ws, int lane) {
    const int h = lane >> 5, lp = lane & 31;
    const int qd = lane >> 4, lq = lane & 15;
    const f32x2 cs = *(const f32x2*)((const float*)(ws + WS_COS128) + t * 64 + 2 * lp), sn = *(const f32x2*)((const float*)(ws + WS_SIN128) + t * 64 + 2 * lp);
    const f32x2 cs6 = *(const f32x2*)((const float*)(ws + WS_COS64) + t * 32 + 2 * lq), sn6 = *(const f32x2*)((const float*)(ws + WS_SIN64) + t * 32 + 2 * lq);
    unsigned xa[19], xb[19]; f32x2 g1[19], g2[19]; unsigned ya[5], yb[5];
#pragma unroll
    for (int it = 0; it < 19; ++it) {
        const int hh = 2 * it + h;
        int col, gi;
        if (hh < 10) { col = C_QA + hh * 128; gi = 0; }
        else if (hh < 12) { col = C_KA + (hh - 10) * 128; gi = 1; }
        else if (hh < 22) { col = C_QB + (hh - 12) * 128; gi = 2; }
        else if (hh < 23) { col = C_KB; gi = 3; }
        else if (hh < 35) { col = C_QC + (hh - 23) * 128; gi = 4; }
        else { col = C_KC + (hh - 35) * 128; gi = 5; }
        xa[it] = *(const unsigned*)(P + col + 2 * lp); xb[it] = *(const unsigned*)(P + col + 64 + 2 * lp);
        g1[it] = *(const f32x2*)(gain + gi * 128 + 2 * lp); g2[it] = *(const f32x2*)(gain + gi * 128 + 64 + 2 * lp);
    }
#pragma unroll
    for (int it = 0; it < 5; ++it) {
        const int hh = 4 * it + qd; const int col = (hh < 16) ? C_QI + hh * 64 : C_KI;
        ya[it] = *(const unsigned*)(P + col + 2 * lq); yb[it] = *(const unsigned*)(P + col + 32 + 2 * lq);
    }
    const unsigned vbw = *(const unsigned*)(P + C_VB + 2 * lane);
    const unsigned wiw = (lane < 8) ? *(const unsigned*)(P + C_WI + 2 * lane) : 0u;
    const size_t bt = (size_t)b * T + t;
#pragma unroll
    for (int it = 0; it < 19; ++it) {
        const int hh = 2 * it + h;
        bf16_t* dst; bool isq;
        if (hh < 10) { dst = (bf16_t*)(ws + WS_QA) + ((size_t)(b * 10 + hh) * T + t) * 128; isq = true; }
        else if (hh < 12) { dst = (bf16_t*)(ws + WS_KA) + ((size_t)(b * 2 + (hh - 10)) * T + t) * 128; isq = false; }
        else if (hh < 22) { dst = (bf16_t*)(ws + WS_QB) + (bt * 10 + (hh - 12)) * 128; isq = true; }
        else if (hh < 23) { dst = (bf16_t*)(ws + WS_KB) + bt * 128; isq = false; }
        else if (hh < 35) { const int hc = hh - 23, grp = hc >> 2, sh = 2 * grp, dil = 1 << sh; const int pos = (t & (dil - 1)) * (T >> sh) + (t >> sh);
            dst = (bf16_t*)(ws + WS_QC) + ((size_t)(b * 12 + hc) * T + pos) * 128; isq = true; }
        else { const int grp = hh - 35, sh = 2 * grp, dil = 1 << sh; const int pos = (t & (dil - 1)) * (T >> sh) + (t >> sh);
            dst = (bf16_t*)(ws + WS_KC) + ((size_t)(b * 3 + grp) * T + pos) * 128; isq = false; }
        const unsigned a = xa[it], bq = xb[it];
        const float x1a = bf_lo(a), x1b = bf_hi(a), x2a = bf_lo(bq), x2b = bf_hi(bq);
        float ss = (x1a * x1a + x1b * x1b) + (x2a * x2a + x2b * x2b);
#pragma unroll
        for (int o = 1; o < 32; o <<= 1) ss += __shfl_xor(ss, o);
        const float rstd = __builtin_amdgcn_rsqf(ss * (1.0f / 128.0f) + EPS);
        const float sc = isq ? QSCALE : 1.0f;
        const float y1a = x1a * rstd * g1[it].x, y1b = x1b * rstd * g1[it].y, y2a = x2a * rstd * g2[it].x, y2b = x2b * rstd * g2[it].y;
        const float o1a = (y1a * cs.x - y2a * sn.x) * sc, o1b = (y1b * cs.y - y2b * sn.y) * sc, o2a = (y2a * cs.x + y1a * sn.x) * sc, o2b = (y2b * cs.y + y1b * sn.y) * sc;
        *(unsigned*)(dst + 2 * lp) = pk2(o1a, o1b); *(unsigned*)(dst + 64 + 2 * lp) = pk2(o2a, o2b);
    }
#pragma unroll
    for (int it = 0; it < 5; ++it) {
        const int hh = 4 * it + qd;
        if (hh < 17) {
            bf16_t* dst = (hh < 16) ? (bf16_t*)(ws + WS_QI) + (bt * 16 + hh) * 64 : (bf16_t*)(ws + WS_KI) + bt * 64;
            const unsigned a = ya[it], bq = yb[it];
            const float x1a = bf_lo(a), x1b = bf_hi(a), x2a = bf_lo(bq), x2b = bf_hi(bq);
            *(unsigned*)(dst + 2 * lq) = pk2(x1a * cs6.x - x2a * sn6.x, x1b * cs6.y - x2b * sn6.y); *(unsigned*)(dst + 32 + 2 * lq) = pk2(x2a * cs6.x + x1a * sn6.x, x2b * cs6.y + x1b * sn6.y);
        }
    }
    *(unsigned*)((bf16_t*)(ws + WS_VB) + bt * 128 + 2 * lane) = vbw;
    if (lane < 8) { f32x2 w2 = {bf_lo(wiw), bf_hi(wiw)}; *(f32x2*)((float*)(ws + WS_WI) + bt * 16 + 2 * lane) = w2; }
}
DI void vt_item(const bf16_t* __restrict__ PROJ, bf16_t* __restrict__ VT, int b, int vcol, int dil, int tb, int dc, LAS u32_a* scr, int lane) {
    const int t0 = tb * 128, d0 = dc * 64;
#pragma unroll 4
    for (int i = 0; i < 16; ++i) { const int tt = i * 8 + (lane >> 3), pc = lane & 7;
        const u32x4 v = *(const u32x4*)(PROJ + (size_t)(b * T + t0 + tt) * NPROJ + vcol + d0 + pc * 8);
        scr[tt * 33 + pc * 4 + 0] = v.x; scr[tt * 33 + pc * 4 + 1] = v.y; scr[tt * 33 + pc * 4 + 2] = v.z; scr[tt * 33 + pc * 4 + 3] = v.w; }
    const LAS u16_a* s16 = (const LAS u16_a*)scr;
    const int nchunk = 16 / dil, j = lane & 15, r = j / nchunk, ch = j % nchunk;
    const int pos = r * (T / dil) + t0 / dil + ch * 8;
#pragma unroll 4
    for (int s = 0; s < 16; ++s) {
        const int d = s * 4 + (lane >> 4);
        const LAS u16_a* p = s16 + (r + dil * ch * 8) * 66 + d; const int st = dil * 66;
        u32x4 w;
        w.x = (unsigned)p[0 * st] | ((unsigned)p[1 * st] << 16); w.y = (unsigned)p[2 * st] | ((unsigned)p[3 * st] << 16);
        w.z = (unsigned)p[4 * st] | ((unsigned)p[5 * st] << 16); w.w = (unsigned)p[6 * st] | ((unsigned)p[7 * st] << 16);
        *(u32x4*)(VT + (size_t)(d0 + d) * VTP + pos) = w;
    }
}
DI void p_prep(Frame& F, const float* __restrict__ gain) {
    bf16_t* PROJ = (bf16_t*)(F.ws + WS_PROJ);
    LAS u32_a* scr = (LAS u32_a*)(F.lds + F.wave * 16896);
    for (int it = F.gw; it < NB * 5 * 32 * 2; it += F.ngw) {
        const int dc = it & 1, tb = (it >> 1) & 31, sb = it >> 6, s = sb % 5, b = sb / 5;
        if (s < 2) vt_item(PROJ, (bf16_t*)(F.ws + WS_VTA2) + (size_t)((b * 2 + s) * 128) * VTP, b, C_VA + s * 128, 1, tb, dc, scr, F.lane);
        else { const int g = s - 2; vt_item(PROJ, (bf16_t*)(F.ws + WS_VTC2) + (size_t)((b * 3 + g) * 128) * VTP, b, C_VC + g * 128, g == 0 ? 1 : (g == 1 ? 4 : 16), tb, dc, scr, F.lane); }
    }
    for (int m = F.gw; m < M; m += F.ngw) prep_token(PROJ + (size_t)m * NPROJ, m / T, m % T, gain, F.ws, F.lane);
}
constexpr int BT_WLDS = 18176, BT_KRS = 272, BT_VRS = 336;
static_assert(NWAVES * BT_WLDS <= MISC_OFF && 64 * BT_KRS <= BT_WLDS && 32 * BT_VRS <= BT_WLDS, "band tile LDS map");
template <int MODE, int HP>
DI void band_tile(const bf16_t* __restrict__ qbase, size_t qhs, const bf16_t* __restrict__ kbase, const bf16_t* __restrict__ vt, int L, int W, int q0, float sink2a, float sink2b,
                  bf16_t* __restrict__ oa, bf16_t* __restrict__ oc, float* __restrict__ lse, size_t tok0, int tokstride, int lane, LAS unsigned char* wl) {
    const int n = lane & 15, g = lane >> 4;
    const int k0 = q0 - 128;
    u32x4 kr[12];
#pragma unroll
    for (int i = 0; i < 12; ++i) { int key = k0 + i * 4 + g; key = key < 0 ? 0 : key; kr[i] = *(const u32x4*)(kbase + (size_t)key * 128 + n * 8); }
    bf16x8 qf[HP][4];
    {
        LAS unsigned char* ql = wl + 48 * BT_KRS;
        u32x4 qr[HP][4];
#pragma unroll
        for (int h = 0; h < HP; ++h)
#pragma unroll
            for (int i = 0; i < 4; ++i) qr[h][i] = *(const u32x4*)(qbase + (size_t)h * qhs + (size_t)(q0 + i * 4 + g) * 128 + n * 8);
#pragma unroll
        for (int h = 0; h < HP; ++h) {
#pragma unroll
            for (int i = 0; i < 4; ++i) *(LAS u32x4_a*)(ql + (i * 4 + g) * BT_KRS + n * 16) = qr[h][i];
#pragma unroll
            for (int ks = 0; ks < 4; ++ks) qf[h][ks] = *(const LAS bf16x8_a*)(ql + n * BT_KRS + ks * 64 + g * 16);
        }
    }
    f32x4 s[HP][9];
#pragma unroll
    for (int kg = 0; kg < 3; ++kg) {
#pragma unroll
        for (int i = 0; i < 12; ++i) *(LAS u32x4_a*)(wl + (i * 4 + g) * BT_KRS + n * 16) = kr[i];
        if (kg < 2) {
#pragma unroll
            for (int i = 0; i < 12; ++i) { int key = k0 + (kg + 1) * 48 + i * 4 + g; key = key < 0 ? 0 : key; kr[i] = *(const u32x4*)(kbase + (size_t)key * 128 + n * 8); }
        }
#pragma unroll
        for (int q = 0; q < 3; ++q) {
            f32x4 acc[HP];
#pragma unroll
            for (int h = 0; h < HP; ++h) acc[h] = (f32x4){0.f, 0.f, 0.f, 0.f};
#pragma unroll
            for (int ks = 0; ks < 4; ++ks) { const bf16x8 kf = *(const LAS bf16x8_a*)(wl + (q * 16 + n) * BT_KRS + ks * 64 + g * 16);
#pragma unroll
                for (int h = 0; h < HP; ++h) acc[h] = MFMA16(kf, qf[h][ks], acc[h]); }
#pragma unroll
            for (int h = 0; h < HP; ++h) s[h][kg * 3 + q] = acc[h];
        }
    }
    int voff[10], vlds[10];
#pragma unroll
    for (int j = 0; j < 10; ++j) { const int pi = j * 64 + lane, vrow = pi / 20, vpc = pi - vrow * 20; int pos = k0 + vpc * 8; pos = pos < 0 ? 0 : (pos > L - 8 ? L - 8 : pos);
        voff[j] = vrow * VTP + pos; vlds[j] = vrow * BT_VRS + vpc * 16; }
    u32x4 vr[10];
#pragma unroll
    for (int j = 0; j < 10; ++j) vr[j] = *(const u32x4*)(vt + voff[j]);
    const int qpos = q0 + n;
    const int mlo = (qpos - W + 1) > 0 ? (qpos - W + 1) : 0, mbase = k0 + 4 * g - mlo; const unsigned mspan = (unsigned)(qpos - mlo);
    float inv[HP], mxh[HP], sumh[HP];
    bf16x8 pf[HP][5];
#pragma unroll
    for (int h = 0; h < HP; ++h) {
        const float sink2 = h ? sink2b : sink2a;
        float mx = -INFINITY;
#pragma unroll
        for (int kt = 0; kt < 9; ++kt)
#pragma unroll
            for (int i = 0; i < 4; ++i) { const bool ok = (unsigned)(mbase + kt * 16 + i) <= mspan;
                s[h][kt][i] = ok ? s[h][kt][i] : -INFINITY; mx = fmaxf(mx, s[h][kt][i]); }
        mx = fmaxf(mx, __shfl_xor(mx, 16)); mx = fmaxf(mx, __shfl_xor(mx, 32));
        if (MODE == 0) mx = fmaxf(mx, sink2);
        float sum = 0.f;
#pragma unroll
        for (int kt = 0; kt < 9; ++kt)
#pragma unroll
            for (int i = 0; i < 4; ++i) { const float p = exp2f(s[h][kt][i] - mx); s[h][kt][i] = p; sum += p; }
        sum += __shfl_xor(sum, 16); sum += __shfl_xor(sum, 32);
        if (MODE == 0) sum += exp2f(sink2 - mx);
        inv[h] = 1.0f / sum; mxh[h] = mx; sumh[h] = sum;
#pragma unroll
        for (int jj = 0; jj < 5; ++jj) {
            u32x4 w; w.x = pk2(s[h][2 * jj][0], s[h][2 * jj][1]); w.y = pk2(s[h][2 * jj][2], s[h][2 * jj][3]);
            if (2 * jj + 1 < 9) { w.z = pk2(s[h][2 * jj + 1 < 9 ? 2 * jj + 1 : 0][0], s[h][2 * jj + 1 < 9 ? 2 * jj + 1 : 0][1]); w.w = pk2(s[h][2 * jj + 1 < 9 ? 2 * jj + 1 : 0][2], s[h][2 * jj + 1 < 9 ? 2 * jj + 1 : 0][3]); }
            else { w.z = 0u; w.w = 0u; }
            pf[h][jj] = __builtin_bit_cast(bf16x8, w);
        }
    }
    const size_t tok = tok0 + (size_t)(q0 + n) * tokstride;
    u32x2 ob[HP][8];
#pragma unroll
    for (int dg = 0; dg < 4; ++dg) {
#pragma unroll
        for (int j = 0; j < 10; ++j) *(LAS u32x4_a*)(wl + vlds[j]) = vr[j];
        if (dg < 3) {
#pragma unroll
            for (int j = 0; j < 10; ++j) vr[j] = *(const u32x4*)(vt + (size_t)((dg + 1) * 32) * VTP + voff[j]);
        }
#pragma unroll
        for (int h2 = 0; h2 < 2; ++h2) {
            const int dt = dg * 2 + h2;
            f32x4 o[HP];
#pragma unroll
            for (int h = 0; h < HP; ++h) o[h] = (f32x4){0.f, 0.f, 0.f, 0.f};
#pragma unroll
            for (int jj = 0; jj < 5; ++jj) {
                const LAS unsigned char* vp = wl + (h2 * 16 + n) * BT_VRS + (32 * jj + 4 * g) * 2;
                const u32x2 va = *(const LAS u32x2_a*)vp, vb = *(const LAS u32x2_a*)(vp + 32);
                u32x4 w; w.x = va.x; w.y = va.y; w.z = vb.x; w.w = vb.y;
#pragma unroll
                for (int h = 0; h < HP; ++h) o[h] = MFMA16(__builtin_bit_cast(bf16x8, w), pf[h][jj], o[h]);
            }
#pragma unroll
            for (int h = 0; h < HP; ++h) {
                const f32x4 on = o[h] * inv[h];
                if (MODE == 0) { const f32x4 o8 = on * O8_SCALE; int q8 = 0; q8 = __builtin_amdgcn_cvt_pk_fp8_f32(CL8(o8[0]), CL8(o8[1]), q8, false); q8 = __builtin_amdgcn_cvt_pk_fp8_f32(CL8(o8[2]), CL8(o8[3]), q8, true); ob[h][dt].x = (unsigned)q8; ob[h][dt].y = 0u; }
                else { ob[h][dt].x = pk2(on[0], on[1]); ob[h][dt].y = pk2(on[2], on[3]); }
            }
        }
    }
#pragma unroll
    for (int h = 0; h < HP; ++h) {
        if (MODE == 0) {
#pragma unroll
            for (int dt = 0; dt < 8; ++dt) *(LAS u32_a*)(wl + n * BT_KRS + dt * 16 + 4 * g) = ob[h][dt].x;
#pragma unroll
            for (int i = 0; i < 4; ++i) { const int row = i * 4 + g; const size_t tk = tok0 + (size_t)(q0 + row) * tokstride;
                *(u32x2*)((unsigned char*)oa + tk * 1280 + h * 128 + n * 8) = *(const LAS u32x2_a*)(wl + row * BT_KRS + n * 8); }
        } else {
#pragma unroll
            for (int dt = 0; dt < 8; ++dt) *(LAS u32x2_a*)(wl + n * BT_KRS + (dt * 16 + 4 * g) * 2) = ob[h][dt];
#pragma unroll
            for (int i = 0; i < 4; ++i) { const int row = i * 4 + g; const size_t tk = tok0 + (size_t)(q0 + row) * tokstride;
                *(u32x4*)(oc + tk * 512 + h * 128 + n * 8) = *(const LAS u32x4_a*)(wl + row * BT_KRS + n * 16); }
        }
        if (MODE == 1 && g == 0) lse[tok * 4 + h] = LN2 * (mxh[h] + log2f(sumh[h]));
    }
}
DI void p_attn1(Frame& F, const float* __restrict__ sinks) {
    for (int it = F.gw; it < NB * 2 * 256 * 2; it += F.ngw) {
        const int hp = it & 1; int r = it >> 1; const int qt = r & 255; r >>= 8; const int kvh = r & 1, b = r >> 1;
        const int head = kvh * 5 + hp * 2;
        band_tile<0, 2>((const bf16_t*)(F.ws + WS_QA) + (size_t)(b * 10 + head) * T * 128, (size_t)T * 128, (const bf16_t*)(F.ws + WS_KA) + (size_t)(b * 2 + kvh) * T * 128,
                     (const bf16_t*)(F.ws + WS_VTA2) + (size_t)((b * 2 + kvh) * 128) * VTP, T, 128, qt * 16, sinks[head] * LOG2E, sinks[head + 1] * LOG2E,
                     (bf16_t*)((unsigned char*)(F.ws + WS_OA) + head * 128), nullptr, nullptr, (size_t)b * T, 1, F.lane, F.lds + F.wave * BT_WLDS);
    }
    for (int it = F.gw - F.ngw / 2; it < NB * 2 * 256; it += F.ngw) {
        if (it < 0) continue;
        int r = it; const int qt = r & 255; r >>= 8; const int kvh = r & 1, b = r >> 1;
        const int head = kvh * 5 + 4;
        band_tile<0, 1>((const bf16_t*)(F.ws + WS_QA) + (size_t)(b * 10 + head) * T * 128, 0, (const bf16_t*)(F.ws + WS_KA) + (size_t)(b * 2 + kvh) * T * 128,
                     (const bf16_t*)(F.ws + WS_VTA2) + (size_t)((b * 2 + kvh) * 128) * VTP, T, 128, qt * 16, sinks[head] * LOG2E, 0.f,
                     (bf16_t*)((unsigned char*)(F.ws + WS_OA) + head * 128), nullptr, nullptr, (size_t)b * T, 1, F.lane, F.lds + F.wave * BT_WLDS);
    }
    for (int it = F.gw; it < NB * 3 * 256 * 2; it += F.ngw) {
        const int j = (it & 1) * 2; int r = it >> 1; const int tile = r & 255; r >>= 8; const int grp = r % 3, b = r / 3;
        const int dil = grp == 0 ? 1 : (grp == 1 ? 4 : 16), L = T / dil, tpr = L / 16, res = tile / tpr, qt = tile % tpr;
        band_tile<1, 2>((const bf16_t*)(F.ws + WS_QC) + ((size_t)(b * 12 + grp * 4 + j) * T + (size_t)res * L) * 128, (size_t)T * 128, (const bf16_t*)(F.ws + WS_KC) + ((size_t)(b * 3 + grp) * T + (size_t)res * L) * 128,
                     (const bf16_t*)(F.ws + WS_VTC2) + (size_t)((b * 3 + grp) * 128) * VTP + (size_t)res * L, L, 129, qt * 16, 0.f, 0.f,
                     nullptr, (bf16_t*)(F.ws + WS_OCG) + (size_t)grp * M * 512 + j * 128, (float*)(F.ws + WS_LSE) + (size_t)grp * M * 4 + j, (size_t)b * T + res, dil, F.lane, F.lds + F.wave * BT_WLDS);
    }
}
#ifndef MK_SPDUP
#define MK_SPDUP 0
#endif
#define SPDUP(k) (((MK_SPDUP) >> (k)) & 1)
#ifndef SP_KD
#define SP_KD 3
#endif
#ifndef SP_VD
#define SP_VD 3
#endif
constexpr int KI_RS = 144, KI_BUF = 128 * KI_RS;
constexpr int SP_SEL_OFF = 2 * KI_BUF, SP_V_OFF = SP_SEL_OFF + NWAVES * 1024, SP_V_RS = 272, SP_V_WAVE = 32 * SP_V_RS;
static_assert(SP_V_OFF + NWAVES * SP_V_WAVE <= MISC_OFF, "sparse LDS map");
DI void sparse_block(Frame& F, int b, int t0) {
    int lane = F.lane, tid = F.tid;
    asm volatile("" : "+v"(lane), "+v"(tid));
    const int r = lane & 15, g = lane >> 4;
    const int t = t0 + F.wave, m = b * T + t;
    LAS unsigned char* kibuf = F.lds;
    LAS u32_a* sel = (LAS u32_a*)(F.lds + SP_SEL_OFF) + F.wave * 256;
    LAS unsigned char* vbuf = F.lds + SP_V_OFF + F.wave * SP_V_WAVE;
    const int nch_blk = ((t0 + 7) >> 6) + 1, nch = (t >> 6) + 1;
    const bf16_t* qirow = (const bf16_t*)(F.ws + WS_QI) + ((size_t)m * 16 + r) * 64 + g * 16;
    const bf16x8 qa0 = *(const bf16x8*)qirow, qa1 = *(const bf16x8*)(qirow + 8);
    float wh[4];
    { const f32x4 wv = *(const f32x4*)((const float*)(F.ws + WS_WI) + (size_t)m * 16 + 4 * g); wh[0] = wv[0]; wh[1] = wv[1]; wh[2] = wv[2]; wh[3] = wv[3]; }
    unsigned key[64];
#pragma unroll
    for (int c = 0; c < 64; ++c) key[c] = 0u;
    const bf16_t* kig = (const bf16_t*)(F.ws + WS_KI) + (size_t)(b * T) * 64 + tid * 8;
    const int srow = tid >> 3, spc = tid & 7;
  for (int rp = 0; rp <= SPDUP(0); ++rp) {
    const int nst = (nch_blk + 1) >> 1;
    u32x4 stg[2][2];
    {   const u32x4 s0 = *(const u32x4*)kig, s1 = *(const u32x4*)(kig + 64 * 64);
        stg[1][0] = (u32x4){0u, 0u, 0u, 0u}; stg[1][1] = stg[1][0]; stg[0][0] = stg[1][0]; stg[0][1] = stg[1][0];
        if (1 < nst) { stg[1][0] = *(const u32x4*)(kig + 128 * 64); stg[1][1] = *(const u32x4*)(kig + 192 * 64); }
        *(LAS u32x4_a*)(kibuf + srow * KI_RS + spc * 16) = s0; *(LAS u32x4_a*)(kibuf + (64 + srow) * KI_RS + spc * 16) = s1; }
    __syncthreads();
#pragma unroll
    for (int ps = 0; ps < 32; ++ps) {
      if (ps < nst) {
        if (ps + 2 < nst) { stg[ps & 1][0] = *(const u32x4*)(kig + (ps + 2) * 128 * 64); stg[ps & 1][1] = *(const u32x4*)(kig + (ps + 2) * 128 * 64 + 64 * 64); }
#pragma unroll
        for (int hc = 0; hc < 2; ++hc) {
          const int c = 2 * ps + hc;
          if (c < nch) {
            const LAS unsigned char* kb = kibuf + (ps & 1) * KI_BUF + hc * 64 * KI_RS;
            bf16x8 kb0[4], kb1[4];
#pragma unroll
            for (int j = 0; j < 4; ++j) { kb0[j] = *(const LAS bf16x8_a*)(kb + (j * 16 + r) * KI_RS + g * 32); kb1[j] = *(const LAS bf16x8_a*)(kb + (j * 16 + r) * KI_RS + g * 32 + 16); }
            f32x4 acc[4];
#pragma unroll
            for (int j = 0; j < 4; ++j) acc[j] = MFMA16(qa0, kb0[j], ((f32x4){0.f, 0.f, 0.f, 0.f}));
#pragma unroll
            for (int j = 0; j < 4; ++j) acc[j] = MFMA16(qa1, kb1[j], acc[j]);
            float part[4];
#pragma unroll
            for (int j = 0; j < 4; ++j) {
                float rl[4];
#pragma unroll
                for (int i = 0; i < 4; ++i) { const int bi = (int)__float_as_uint(acc[j][i]); rl[i] = __uint_as_float((unsigned)(bi > 0 ? bi : 0)); }
                part[j] = (wh[0] * rl[0] + wh[1] * rl[1]) + (wh[2] * rl[2] + wh[3] * rl[3]);
            }
            const auto sw0 = __builtin_amdgcn_permlane32_swap(__float_as_uint(part[0]), __float_as_uint(part[2]), false, false);
            const auto sw1 = __builtin_amdgcn_permlane32_swap(__float_as_uint(part[1]), __float_as_uint(part[3]), false, false);
            const float a0 = __uint_as_float(sw0[0]) + __uint_as_float(sw0[1]);
            const float a1 = __uint_as_float(sw1[0]) + __uint_as_float(sw1[1]);
            const bool odd = (g & 1) != 0;
            const float rv = __shfl_xor(odd ? a0 : a1, 16);
            const float sc = (odd ? a1 : a0) + rv;
            const unsigned u = __float_as_uint(sc);
            const unsigned ku = (u & 0x80000000u) ? ~u : (u | 0x80000000u);
            key[c] = (c * 64 + lane <= t) ? ku : 0u;
          }
        }
        if (ps + 1 < nst) { LAS unsigned char* nb = kibuf + ((ps + 1) & 1) * KI_BUF;
            *(LAS u32x4_a*)(nb + srow * KI_RS + spc * 16) = stg[(ps + 1) & 1][0]; *(LAS u32x4_a*)(nb + (64 + srow) * KI_RS + spc * 16) = stg[(ps + 1) & 1][1]; }
        __syncthreads();
      }
    }
  }
    int nsel;
  for (int rp = 0; rp <= SPDUP(1); ++rp) {
    if (t < TOPK) {
        nsel = t + 1;
#pragma unroll
        for (int i = 0; i < 4; ++i) { const int p = i * 64 + lane; sel[p] = (p <= t) ? (unsigned)p : 0u; }
    } else {
        unsigned thr = 0u;
        const int ngrp = (nch + 7) >> 3;
        bool exact = false;
        for (int bit = 31; bit >= 0; --bit) {
            const unsigned cand = thr | (1u << bit);
            int cnt = 0;
#pragma unroll
            for (int gq = 0; gq < 8; ++gq) if (gq < ngrp) {
                unsigned long long mk[8];
#pragma unroll
                for (int j = 0; j < 8; ++j) mk[j] = __ballot(key[gq * 8 + j] >= cand);
#pragma unroll
                for (int j = 0; j < 8; ++j) cnt += __popcll(mk[j]);
            }
            if (cnt >= TOPK) thr = cand;
            if (cnt == TOPK) { exact = true; break; }
        }
        int base = 0;
        if (exact) {
#pragma unroll
            for (int gq = 0; gq < 8; ++gq) if (gq < ngrp) {
#pragma unroll
              for (int j = 0; j < 8; ++j) {
                const int c = gq * 8 + j;
                const bool pred = key[c] >= thr;
                const unsigned long long mp = __ballot(pred);
                const int pos = base + (int)__builtin_amdgcn_mbcnt_hi((unsigned)(mp >> 32), __builtin_amdgcn_mbcnt_lo((unsigned)mp, 0u));
                if (pred) sel[pos] = (unsigned)(c * 64 + lane);
                base += __popcll(mp);
              }
            }
        } else {
        int ngt = 0;
#pragma unroll
        for (int gq = 0; gq < 8; ++gq) if (gq < ngrp) {
#pragma unroll
            for (int j = 0; j < 8; ++j) ngt += __popcll(__ballot(key[gq * 8 + j] > thr));
        }
        const int need = TOPK - ngt;
        int tieb = 0;
#pragma unroll
        for (int gq = 0; gq < 8; ++gq) if (gq < ngrp) {
#pragma unroll
          for (int j = 0; j < 8; ++j) {
            const int c = gq * 8 + j;
            const bool gt = key[c] > thr, eq = key[c] == thr;
            const unsigned long long me = __ballot(eq);
            const int trank = tieb + (int)__builtin_amdgcn_mbcnt_hi((unsigned)(me >> 32), __builtin_amdgcn_mbcnt_lo((unsigned)me, 0u));
            const bool pred = gt || (eq && trank < need);
            const unsigned long long mp = __ballot(pred);
            const int pos = base + (int)__builtin_amdgcn_mbcnt_hi((unsigned)(mp >> 32), __builtin_amdgcn_mbcnt_lo((unsigned)mp, 0u));
            if (pred && pos < TOPK) sel[pos] = (unsigned)(c * 64 + lane);
            base += __popcll(mp); tieb += __popcll(me);
          }
        }
        }
        nsel = base < TOPK ? base : TOPK;
#pragma unroll
        for (int i = 0; i < 4; ++i) { const int p = i * 64 + lane; if (p >= nsel) sel[p] = 0u; }
    }
  }
  for (int rp = 0; rp <= SPDUP(2); ++rp) {
    const int hq = r < 10 ? r : 9;
    bf16x8 qb[4];
#pragma unroll
    for (int ks = 0; ks < 4; ++ks) qb[ks] = *(const bf16x8*)((const bf16_t*)(F.ws + WS_QB) + ((size_t)m * 10 + hq) * 128 + ks * 32 + g * 8);
    const bf16_t* kbg = (const bf16_t*)(F.ws + WS_KB) + (size_t)(b * T) * 128;
    f32x4 sv[16];
    float mx = -INFINITY;
    {
        u32x4 kr[SP_KD][8];
#pragma unroll
        for (int j = 0; j < SP_KD; ++j)
#pragma unroll
            for (int i = 0; i < 8; ++i) { const unsigned idx = sel[32 * j + 4 * i + g]; kr[j][i] = *(const u32x4*)(kbg + (size_t)idx * 128 + r * 8); }
#pragma unroll
        for (int pp = 0; pp < 8; ++pp) {
#pragma unroll
            for (int i = 0; i < 8; ++i) *(LAS u32x4_a*)(vbuf + (4 * i + g) * SP_V_RS + r * 16) = kr[pp % SP_KD][i];
            if (pp + SP_KD < 8) {
#pragma unroll
                for (int i = 0; i < 8; ++i) { const unsigned idx = sel[32 * (pp + SP_KD) + 4 * i + g]; kr[pp % SP_KD][i] = *(const u32x4*)(kbg + (size_t)idx * 128 + r * 8); }
            }
#pragma unroll
            for (int q = 0; q < 2; ++q) {
                f32x4 acc = {0.f, 0.f, 0.f, 0.f};
#pragma unroll
                for (int ks = 0; ks < 4; ++ks) { const bf16x8 kf = *(const LAS bf16x8_a*)(vbuf + (q * 16 + r) * SP_V_RS + ks * 64 + g * 16); acc = MFMA16(kf, qb[ks], acc); }
                sv[2 * pp + q] = acc;
            }
        }
    }
    const int nlim = nsel - 4 * g;
#pragma unroll
    for (int tl = 0; tl < 16; ++tl)
#pragma unroll
        for (int i = 0; i < 4; ++i) { sv[tl][i] = (tl * 16 + i < nlim) ? sv[tl][i] : -INFINITY; mx = fmaxf(mx, sv[tl][i]); }
    mx = fmaxf(mx, __shfl_xor(mx, 16)); mx = fmaxf(mx, __shfl_xor(mx, 32));
    const bf16_t* vbg = (const bf16_t*)(F.ws + WS_VB) + (size_t)(b * T) * 128 + r * 8;
    int psl[8];
#pragma unroll
    for (int i = 0; i < 8; ++i) { const int sr = 4 * i + g, e = sr & 7, gs = sr >> 3; psl[i] = (e < 4) ? 4 * gs + e : 16 + 4 * gs + (e - 4); }
    u32x4 vr[SP_VD][8];
#pragma unroll
    for (int j = 0; j < SP_VD; ++j)
#pragma unroll
        for (int i = 0; i < 8; ++i) { const unsigned idx = sel[32 * j + psl[i]]; vr[j][i] = *(const u32x4*)(vbg + (size_t)idx * 128); }
    float sum = 0.f;
#pragma unroll
    for (int tl = 0; tl < 16; ++tl)
#pragma unroll
        for (int i = 0; i < 4; ++i) { const float p = __builtin_amdgcn_exp2f(sv[tl][i] - mx); sum += p; sv[tl][i] = p; }
    sum += __shfl_xor(sum, 16); sum += __shfl_xor(sum, 32);
    bf16x8 pf[8];
#pragma unroll
    for (int c = 0; c < 8; ++c) { u32x4 w; w.x = pk2(sv[2 * c][0], sv[2 * c][1]); w.y = pk2(sv[2 * c][2], sv[2 * c][3]); w.z = pk2(sv[2 * c + 1][0], sv[2 * c + 1][1]); w.w = pk2(sv[2 * c + 1][2], sv[2 * c + 1][3]);
        pf[c] = __builtin_bit_cast(bf16x8, w); }
    f32x4 o[8];
#pragma unroll
    for (int dt = 0; dt < 8; ++dt) o[dt] = (f32x4){0.f, 0.f, 0.f, 0.f};
    typedef short s16x4 __attribute__((ext_vector_type(4)));
    const LAS unsigned char* trb = vbuf + (g * 8 + (r >> 2)) * SP_V_RS + (r & 3) * 8;
#pragma unroll
    for (int c = 0; c < 8; ++c) {
#pragma unroll
        for (int i = 0; i < 8; ++i) *(LAS u32x4_a*)(vbuf + (4 * i + g) * SP_V_RS + r * 16) = vr[c % SP_VD][i];
        if (c + SP_VD < 8) {
#pragma unroll
            for (int i = 0; i < 8; ++i) { const unsigned idx = sel[32 * (c + SP_VD) + psl[i]]; vr[c % SP_VD][i] = *(const u32x4*)(vbg + (size_t)idx * 128); }
        }
#pragma unroll
        for (int dt = 0; dt < 8; ++dt) {
            const s16x4 t0 = __builtin_amdgcn_ds_read_tr16_b64_v4i16((LAS s16x4*)(trb + dt * 32));
            const s16x4 t1 = __builtin_amdgcn_ds_read_tr16_b64_v4i16((LAS s16x4*)(trb + 4 * SP_V_RS + dt * 32));
            const bf16x8 vf = __builtin_shufflevector(t0, t1, 0, 1, 2, 3, 4, 5, 6, 7);
            o[dt] = MFMA16(pf[c], vf, o[dt]);
        }
    }
    unsigned char* ob = F.ws + WS_OB + (size_t)m * 1280 + r;
#pragma unroll
    for (int i = 0; i < 4; ++i) {
        const int head = 4 * g + i;
        const float sh = __shfl(sum, head < 10 ? head : 0);
        const float inv = 1.0f / sh;
        if (head < 10) {
#pragma unroll
            for (int dt = 0; dt < 8; ++dt) ob[head * 128 + dt * 16] = (unsigned char)(__builtin_amdgcn_cvt_pk_fp8_f32(CL8(o[dt][i] * inv * O8_SCALE), 0.f, 0, false) & 0xff);
        }
    }
  }
}
DI void p_attn2(Frame& F) {
    for (int pi = blockIdx.x; pi < NB * 256; pi += F.G) {
        const int b = pi >> 8, c = pi & 255;
        for (int k2 = 0; k2 < 2; ++k2) sparse_block(F, b, (k2 ? 511 - c : c) * 8);
    }
    const bf16_t* ocg = (const bf16_t*)(F.ws + WS_OCG); const float* lse = (const float*)(F.ws + WS_LSE);
    for (int m = F.gw; m < M; m += F.ngw) {
        const int j = F.lane >> 4, d8 = (F.lane & 15) * 8;
        const float l0 = lse[(size_t)m * 4 + j], l1 = lse[(size_t)(M + m) * 4 + j], l2 = lse[(size_t)(2 * M + m) * 4 + j];
        const float mx = fmaxf(l0, fmaxf(l1, l2));
        float e0 = __expf(l0 - mx), e1 = __expf(l1 - mx), e2 = __expf(l2 - mx);
        const float inv = 1.0f / (e0 + e1 + e2); e0 *= inv; e1 *= inv; e2 *= inv;
        const bf16_t* p0 = ocg + (size_t)m * 512 + j * 128 + d8;
        const u32x4 a = *(const u32x4*)p0, b = *(const u32x4*)(p0 + (size_t)M * 512), c = *(const u32x4*)(p0 + (size_t)2 * M * 512);
        int w8[2] = {0, 0};
#pragma unroll
        for (int q = 0; q < 4; ++q) { const float x0 = (bf_lo(a[q]) * e0 + bf_lo(b[q]) * e1 + bf_lo(c[q]) * e2) * O8_SCALE, x1 = (bf_hi(a[q]) * e0 + bf_hi(b[q]) * e1 + bf_hi(c[q]) * e2) * O8_SCALE;
            if (q & 1) w8[q >> 1] = __builtin_amdgcn_cvt_pk_fp8_f32(CL8(x0), CL8(x1), w8[q >> 1], true); else w8[q >> 1] = __builtin_amdgcn_cvt_pk_fp8_f32(CL8(x0), CL8(x1), w8[q >> 1], false); }
        u32x2 w; w.x = (unsigned)w8[0]; w.y = (unsigned)w8[1];
        *(u32x2*)(F.ws + WS_OC + (size_t)m * 512 + j * 128 + d8) = w;
    }
}

DI void p_fixup(Frame& F, const float* __restrict__ cw) {
    const float* FIX = (const float*)(F.ws + WS_FIX); const bf16_t* HALO = (const bf16_t*)(F.ws + WS_HALO); bf16_t* ACT = (bf16_t*)(F.ws + WS_ACT);
    for (int it = F.gw; it < (M / 256) * (DFF / 128); it += F.ngw) {
        const int pm = it / (DFF / 128), pn = it % (DFF / 128), j = F.lane >> 5, c4 = (F.lane & 31) * 4, ch = pn * 128 + c4;
        const float* fx = FIX + ((size_t)it * 2 + j) * 256 + c4;
        f32x4 cg = *(const f32x4*)fx, cv = *(const f32x4*)(fx + 128);
        if ((pm * 256) % T != 0) {
            const bf16_t* hp = HALO + ((size_t)(it - DFF / 128) * 2) * 256 + c4;
            const u32x2 g0 = *(const u32x2*)hp, v0 = *(const u32x2*)(hp + 128), g1 = *(const u32x2*)(hp + 256), v1 = *(const u32x2*)(hp + 256 + 128);
            f32x4 w0g = *(const f32x4*)(cw + ch), w1g = *(const f32x4*)(cw + NUP + ch), w0v = *(const f32x4*)(cw + DFF + ch), w1v = *(const f32x4*)(cw + NUP + DFF + ch);
#pragma unroll
            for (int q = 0; q < 4; ++q) { w0g[q] = bf_lo(pk2(w0g[q], 0.f)); w1g[q] = bf_lo(pk2(w1g[q], 0.f)); w0v[q] = bf_lo(pk2(w0v[q], 0.f)); w1v[q] = bf_lo(pk2(w1v[q], 0.f)); }
            const f32x4 h0g = {bf_lo(g0.x), bf_hi(g0.x), bf_lo(g0.y), bf_hi(g0.y)}, h1g = {bf_lo(g1.x), bf_hi(g1.x), bf_lo(g1.y), bf_hi(g1.y)};
            const f32x4 h0v = {bf_lo(v0.x), bf_hi(v0.x), bf_lo(v0.y), bf_hi(v0.y)}, h1v = {bf_lo(v1.x), bf_hi(v1.x), bf_lo(v1.y), bf_hi(v1.y)};
            if (j == 0) { cg += w0g * h0g + w1g * h1g; cv += w0v * h0v + w1v * h1v; }
            else { cg += w0g * h1g; cv += w0v * h1v; }
        }
        u32x2 o; o.x = pk2(cg[0] * __builtin_amdgcn_rcpf(1.0f + __expf(-cg[0])) * cv[0], cg[1] * __builtin_amdgcn_rcpf(1.0f + __expf(-cg[1])) * cv[1]); o.y = pk2(cg[2] * __builtin_amdgcn_rcpf(1.0f + __expf(-cg[2])) * cv[2], cg[3] * __builtin_amdgcn_rcpf(1.0f + __expf(-cg[3])) * cv[3]);
        *(u32x2*)(ACT + (size_t)(pm * 256 + j) * DFF + ch) = o;
    }
}

constexpr int N_PHASES = 1 + 11 * DEPTH;
#ifndef GP_ALIGN
#define GP_ALIGN true
#endif
#ifndef GP_SP2
#define GP_SP2 true
#endif
#ifndef MK_PHASE_MASK
#define MK_PHASE_MASK 0xFFF
#endif
#define EN(j) (((MK_PHASE_MASK) >> (j)) & 1)
#ifndef MK_DUP_MASK
#define MK_DUP_MASK 0
#endif
#define DUP(j) (((MK_DUP_MASK) >> (j)) & 1)
#define REPS(j) for (int rep = 0; rep <= DUP(j); ++rep)
#define RSEAM(j) do { if (rep < DUP(j)) { XcdBarrier b2_ = bar; unsigned* p_ = b2_.bar; asm volatile("" : "+s"(p_)); b2_.bar = glob(p_); xcd_barrier(b2_); } } while (0)
struct Args { const float* in[14]; float* out; unsigned char* ws; int ph_lo, ph_hi, li, pad; };
__global__ void __launch_bounds__(NWAVES * 64, 2) mk_fwd(Args args) {
    extern __shared__ __attribute__((aligned(16))) unsigned char lds_raw[];
    Frame F;
    F.lds = (LAS unsigned char*)lds_raw;
    F.tid = threadIdx.x; F.lane = F.tid & 63; F.wave = __builtin_amdgcn_readfirstlane(F.tid >> 6);
    F.G = gridDim.x; F.gw = blockIdx.x * NWAVES + F.wave; F.ngw = F.G * NWAVES; F.ws = glob(args.ws);
    volatile LAS unsigned* MISC = (volatile LAS unsigned*)(F.lds + MISC_OFF);
    if (F.tid < 64) MISC[F.tid] = 0u;
    __syncthreads();
    const int lo = args.ph_lo, hi = args.ph_hi;
    unsigned* ctl = (unsigned*)(glob(args.ws) + WS_CTL);
    XcdBarrier bar; bar.bar = ctl + CW_BAR + args.li * XCD_BAR_WORDS; bar.x = 0u; bar.st = MISC + 8;
    if (hi - lo > 1) bar = xcd_barrier_post(ctl + CW_BAR + args.li * XCD_BAR_WORDS, MISC + 8);
#define IN(k) (lo <= (k) && (k) < hi)
#define LAUNDER() do { int _t = threadIdx.x; asm volatile("" : "+v"(_t)); F.tid = _t; F.lane = _t & 63; unsigned char* _w = args.ws; asm volatile("" : "+s"(_w)); F.ws = glob(_w); F.in = args.in; { int _g = (int)blockIdx.x * NWAVES + F.wave; asm volatile("" : "+s"(_g)); F.gw = _g; } float* _o = args.out; asm volatile("" : "+s"(_o)); F.out = glob(_o); } while (0)
#define SEAM(k) do { if ((k) + 1 < hi) { XcdBarrier b2_ = bar; unsigned* p_ = b2_.bar; asm volatile("" : "+s"(p_)); b2_.bar = glob(p_); xcd_barrier(b2_); } } while (0)
#define H ((bf16_t*)(F.ws + WS_H))
#define PROJ ((bf16_t*)(F.ws + WS_PROJ))
#define Y ((bf16_t*)(F.ws + WS_Y))
#define U ((bf16_t*)(F.ws + WS_U))
#define ACT ((bf16_t*)(F.ws + WS_ACT))
#define SS ((float*)(F.ws + WS_SS))
#define PART ((float*)(F.ws + WS_PART))

    if (EN(0) && IN(0)) { LAUNDER(); REPS(0) { p_prologue(F, F.in); RSEAM(0); } SEAM(0); }

    for (int l = 0; l < DEPTH; ++l) {
        const int pb = 1 + 11 * l;
#define wl (F.ws + WS_W + (size_t)l * LW)
#define xin ((l == 0) ? glob(F.in[0]) : F.out)
        if (EN(1) && IN(pb + 0)) { LAUNDER();
            if (l == 0) { REPS(1) { p_norm(F, xin, glob(F.in[1]), H, F.ws + WS_H8, SS); RSEAM(1); } }
            else p_rowsum(F, PART, SS + (size_t)(2 * l) * M);
            SEAM(pb + 0); }
        if (EN(2) && IN(pb + 1)) { LAUNDER();
            REPS(2) {
                {   pg8::Gemm g{H, (const bf16_t*)(wl + LW_IN), M, NB16, D}; pg8::StaticOrder S; S.init(M, NB16, F.G, (int)blockIdx.x);
                    pg8::EpiStoreBf16 E{PROJ, NPROJ, SS + (size_t)(2 * l) * M, 1.0f / D, EPS, F.lds + pg8::XL_OFF + F.wave * pg8::XL_WAVE, 1.0f};
                    pg8::gemm_phase<pg8::EpiStoreBf16, pg8::StaticOrder, GP_ALIGN, GP_SP2>(F.lds, g, S, E); }
                {   pg8::Gemm g{(const bf16_t*)(F.ws + WS_H8), (const bf16_t*)(F.ws + WS_WG8 + (size_t)l * NG8 * D), M, NG8, D / 2}; pg8::StaticOrder S; S.init(M, NG8, F.G, (int)blockIdx.x);
                    pg8::EpiStoreBf16 E{PROJ + NB16, NPROJ, SS + (size_t)(2 * l) * M, 1.0f / D, EPS, F.lds + pg8::XL_OFF + F.wave * pg8::XL_WAVE, 1.0f / G8_SCALE};
                    pg8::gemm_phase<pg8::EpiStoreBf16, pg8::StaticOrder, GP_ALIGN, GP_SP2, true>(F.lds, g, S, E); }
                if (F.G == 256 && (int)blockIdx.x >= 96) convert_items(F, F.in, l, CV_IN, CV_SPARE_HI, ((int)blockIdx.x - 96) * NWAVES + F.wave, 160 * NWAVES);
                RSEAM(2);
            }
            SEAM(pb + 1);
        }
        if (EN(3) && IN(pb + 2)) { LAUNDER(); p_prep(F, glob(F.in[3]) + (size_t)l * 6 * 128); SEAM(pb + 2); }
        if (EN(4) && IN(pb + 3)) { LAUNDER(); REPS(4) { p_attn1(F, glob(F.in[4]) + (size_t)l * 10); RSEAM(4); } SEAM(pb + 3); }
        if (EN(5) && IN(pb + 4)) { LAUNDER(); REPS(5) { p_attn2(F); RSEAM(5); } SEAM(pb + 4); }
        if (EN(6) && IN(pb + 5)) { LAUNDER();
            REPS(6) for (int br = 0; br < 3; ++br) {
                const bf16_t* A = (const bf16_t*)(F.ws + (br == 0 ? WS_OA : (br == 1 ? WS_OB : WS_OC)));
                const bf16_t* Bt = (const bf16_t*)(wl + (br == 0 ? LW_BRA : (br == 1 ? LW_BRB : LW_BRC)));
                const int K = br == 2 ? KBR_C : KBR_A, gcol = br == 0 ? C_GA : (br == 1 ? C_GB : C_GC);
                pg8::Gemm g{A, Bt, M, D, K / 2}; pg8::StaticOrder S; S.init(M, D, F.G, (int)blockIdx.x);
                pg8::EpiGate E{Y, D, PROJ + gcol, NPROJ, br == 0 ? 1 : 0, F.lds + pg8::XL_OFF + F.wave * pg8::XL_WAVE, 1.0f / (O8_SCALE * WBR8_SCALE), br == 2 ? F.ws + WS_Y8 : nullptr, Y8_SCALE};
                pg8::gemm_phase<pg8::EpiGate, pg8::StaticOrder, GP_ALIGN, GP_SP2, true>(F.lds, g, S, E);
                if (br == 2) RSEAM(6);
            }
            SEAM(pb + 5);
        }
        if (EN(7) && IN(pb + 6)) { LAUNDER();
            pg8::Gemm g{(const bf16_t*)(F.ws + WS_Y8), (const bf16_t*)(wl + LW_OUT), M, D, D / 2}; pg8::StaticOrder S; S.init(M, D, F.G, (int)blockIdx.x);
            REPS(7) { pg8::EpiResid E{xin, (rep < DUP(7)) ? (float*)U : F.out, D, (rep < DUP(7)) ? nullptr : H, glob(F.in[9]) + (size_t)l * D, PART, F.lds + pg8::XL_OFF + F.wave * pg8::XL_WAVE, (rep < DUP(7)) ? nullptr : F.ws + WS_H8, 1.0f / (Y8_SCALE * WOUT8_SCALE)};
            pg8::gemm_phase<pg8::EpiResid, pg8::StaticOrder, GP_ALIGN, GP_SP2, true>(F.lds, g, S, E); RSEAM(7); }
            SEAM(pb + 6);
        }
        if (EN(8) && IN(pb + 7)) { LAUNDER(); p_rowsum(F, PART, SS + (size_t)(2 * l + 1) * M); SEAM(pb + 7); }
        if (EN(9) && IN(pb + 8)) { LAUNDER();
            REPS(9) {
                {   pg8::Gemm g{H, (const bf16_t*)(wl + LW_UP), M, UP_P * 256, D}; pg8::StaticOrder S; S.init(M, UP_P * 256, F.G, (int)blockIdx.x);
                    pg8::EpiConv E{ACT, SS + (size_t)(2 * l + 1) * M, 1.0f / D, EPS, glob(F.in[11]) + (size_t)l * 3 * NUP, glob(F.in[12]) + (size_t)l * NUP, (float*)(F.ws + WS_FIX), (bf16_t*)(F.ws + WS_HALO), F.lds, F.wave, DFF, 1.0f, 0};
                    pg8::gemm_phase<pg8::EpiConv, pg8::StaticOrder, GP_ALIGN, GP_SP2>(F.lds, g, S, E); }
                {   constexpr int NT8 = NUP / 256 - UP_P;
                    pg8::Gemm g{(const bf16_t*)(F.ws + WS_H8), (const bf16_t*)(wl + LW_UP + (size_t)UP_P * 256 * D * 2), M, NT8 * 256, D / 2}; pg8::StaticOrder S; S.init(M, NT8 * 256, F.G, (int)blockIdx.x);
                    pg8::EpiConv E{ACT, SS + (size_t)(2 * l + 1) * M, 1.0f / D, EPS, glob(F.in[11]) + (size_t)l * 3 * NUP, glob(F.in[12]) + (size_t)l * NUP, (float*)(F.ws + WS_FIX), (bf16_t*)(F.ws + WS_HALO), F.lds, F.wave, DFF, 1.0f / WUP8_SCALE, UP_P};
                    pg8::gemm_phase<pg8::EpiConv, pg8::StaticOrder, GP_ALIGN, GP_SP2, true>(F.lds, g, S, E);
                    constexpr int TAIL8 = (NT8 * 32) % 256;
                    if (F.G == 256 && TAIL8 != 0 && (int)blockIdx.x >= TAIL8 && l + 1 < DEPTH) convert_items(F, F.in, l + 1, CV_SPARE_HI, CV_UP_HI, ((int)blockIdx.x - TAIL8) * NWAVES + F.wave, (F.G - TAIL8) * NWAVES); }
                RSEAM(9); }
            SEAM(pb + 8);
        }
        if (EN(10) && IN(pb + 9)) { LAUNDER(); REPS(10) { p_fixup(F, glob(F.in[11]) + (size_t)l * 3 * NUP); RSEAM(10); } SEAM(pb + 9); }
        if (EN(11) && IN(pb + 10)) { LAUNDER();
            pg8::Gemm g{ACT, (const bf16_t*)(wl + LW_DN), M, D, DFF}; pg8::StaticOrder S; S.init(M, D, F.G, (int)blockIdx.x);
            REPS(11) { pg8::EpiResid E{F.out, (rep < DUP(11)) ? (float*)U : F.out, D, (rep < DUP(11) || l + 1 >= DEPTH) ? nullptr : H, glob(F.in[1]) + (size_t)(l + 1 < DEPTH ? l + 1 : 0) * D, PART, F.lds + pg8::XL_OFF + F.wave * pg8::XL_WAVE, (rep < DUP(11) || l + 1 >= DEPTH) ? nullptr : F.ws + WS_H8, 1.0f};
            pg8::gemm_phase<pg8::EpiResid, pg8::StaticOrder, GP_ALIGN, GP_SP2>(F.lds, g, S, E); RSEAM(11); }
            SEAM(pb + 10);
        }
    }
#undef IN
#undef SEAM
#undef H
#undef PROJ
#undef Y
#undef U
#undef ACT
#undef SS
#undef PART
#undef wl
#undef xin
}

extern "C" void kernel_launch(void* const* d_in, const int* in_sizes, int n_in, void* d_out, int out_size, void* d_ws, size_t ws_size, hipStream_t stream) {
    static int grid = 0;
    if (grid == 0) {
        if (n_in != 14 || in_sizes[0] != M * D || out_size != M * D || ws_size < WS_END) {
            fprintf(stderr, "kernel_launch: built for 14 inputs, x/out of %d floats, >= %zu bytes of workspace; got n_in %d, in0 %d, out %d, ws %zu; nothing launched\n", M * D, (size_t)WS_END, n_in, n_in > 0 ? in_sizes[0] : -1, out_size, ws_size);
            grid = -1; return; }
        int dev = 0, cus = 0, per_cu = 0;
        if (hipGetDevice(&dev) != hipSuccess || hipDeviceGetAttribute(&cus, hipDeviceAttributeMultiprocessorCount, dev) != hipSuccess) { fprintf(stderr, "kernel_launch: device query failed\n"); grid = -1; return; }
        if (hipFuncSetAttribute((const void*)mk_fwd, hipFuncAttributeMaxDynamicSharedMemorySize, LDS_BYTES) != hipSuccess) { fprintf(stderr, "kernel_launch: hipFuncSetAttribute failed\n"); grid = -1; return; }
        if (hipOccupancyMaxActiveBlocksPerMultiprocessor(&per_cu, (const void*)mk_fwd, NWAVES * 64, LDS_BYTES) != hipSuccess || per_cu < 1)
            fprintf(stderr, "kernel_launch: note: occupancy query reports %d workgroups per CU\n", per_cu);
        (void)hipGetLastError();
        grid = cus;
    }
    if (grid < 0) return;
    if (hipMemsetAsync((char*)d_ws + WS_CTL, 0, CTL_ZERO_BYTES, stream) != hipSuccess) { fprintf(stderr, "kernel_launch: memset failed\n"); return; }
    Args a{};
    for (int i = 0; i < 14; ++i) a.in[i] = (const float*)d_in[i];
    a.out = (float*)d_out; a.ws = (unsigned char*)d_ws; a.pad = 0;
#if MK_N_LAUNCHES == 1
    a.ph_lo = 0; a.ph_hi = N_PHASES; a.li = 0;
    hipLaunchKernelGGL(mk_fwd, dim3(grid), dim3(NWAVES * 64), LDS_BYTES, stream, a);
#else
    for (int p = 0; p < N_PHASES; ++p) { a.ph_lo = p; a.ph_hi = p + 1; a.li = p; hipLaunchKernelGGL(mk_fwd, dim3(grid), dim3(NWAVES * 64), LDS_BYTES, stream, a); }
#endif
    const hipError_t le = hipPeekAtLastError();
    if (le != hipSuccess) fprintf(stderr, "kernel_launch: launch failed: %s\n", hipGetErrorName(le));
}
```
